# Optimizing an MI355X kernel written in HIP

```python
import math
import jax, jax.numpy as jnp
from jax import lax
import numpy as np

D_MODEL = 1024
BATCH = 8
SEQ = 4096
DEPTH = 1

ATTN_HEADS = 8
ATTN_HEAD_DIM = 64
ATTN_V_DIM = 2 * ATTN_HEAD_DIM
QK_WIDTH = ATTN_HEADS * 2 * ATTN_HEAD_DIM
ATTN_WIDTH = ATTN_HEADS * ATTN_V_DIM
ROPE_THETA = 500000.0
ROPE_DIM = ATTN_HEAD_DIM // 4
Q_BLOCK = 128
SUBLN_EPS = 1e-5
RNN_WIDTH = 1024
RNN_BLOCKS = 8
RNN_BLOCK_DIM = RNN_WIDTH // RNN_BLOCKS
CONV_WIDTH = 4
LRU_C = 8.0
LN_EPS = 1e-5

IN_WIDTHS = (QK_WIDTH, QK_WIDTH, ATTN_WIDTH, ATTN_WIDTH, RNN_WIDTH, RNN_WIDTH, D_MODEL, D_MODEL)
IN_WIDTH = sum(IN_WIDTHS)
IN_SPLITS = tuple(int(s) for s in np.cumsum(IN_WIDTHS)[:-1])

kernel_name = "hybrid_diffattn_rglru_gated_deepnorm"


def _rope_partial(t, pos):
    inv = ROPE_THETA ** (-jnp.arange(0, ROPE_DIM, 2, dtype=jnp.float32) / ROPE_DIM)
    ang = pos.astype(jnp.float32)[:, None] * inv[None, :]
    cos = jnp.concatenate([jnp.cos(ang), jnp.cos(ang)], -1)[None, :, None, None, :]
    sin = jnp.concatenate([jnp.sin(ang), jnp.sin(ang)], -1)[None, :, None, None, :]
    tr, tp = t[..., :ROPE_DIM], t[..., ROPE_DIM:]
    half = ROPE_DIM // 2
    rot = jnp.concatenate([-tr[..., half:], tr[..., :half]], -1)
    tr = (tr.astype(jnp.float32) * cos + rot.astype(jnp.float32) * sin).astype(t.dtype)
    return jnp.concatenate([tr, tp], -1)


def _diff_attention(q, k, v, lam):
    B, S = q.shape[0], q.shape[1]
    nb = S // Q_BLOCK
    scale = ATTN_HEAD_DIM ** -0.5
    kh = jnp.transpose(k, (0, 2, 3, 1, 4))
    vh = jnp.transpose(v, (0, 2, 1, 3))
    qb = q.reshape(B, nb, Q_BLOCK, ATTN_HEADS, 2, ATTN_HEAD_DIM).transpose(1, 0, 3, 4, 2, 5)
    k_pos = jnp.arange(S)

    def block(args):
        qi, i = args
        s = jnp.einsum('bhmqd,bhmkd->bhmqk', qi, kh).astype(jnp.float32) * scale
        q_pos = i * Q_BLOCK + jnp.arange(Q_BLOCK)
        mask = k_pos[None, :] <= q_pos[:, None]
        p = jax.nn.softmax(jnp.where(mask, s, -jnp.inf), axis=-1)
        a = p[:, :, 0] - lam * p[:, :, 1]
        return jnp.einsum('bhqk,bhkv->bqhv', a.astype(vh.dtype), vh)

    out = lax.map(block, (qb, jnp.arange(nb)))
    return out.transpose(1, 0, 2, 3, 4).reshape(B, S, ATTN_HEADS, ATTN_V_DIM)


def _causal_conv(x, w, b):
    S = x.shape[1]
    xp = jnp.pad(x, ((0, 0), (CONV_WIDTH - 1, 0), (0, 0)))
    out = b
    for j in range(CONV_WIDTH):
        out = out + w[j] * xp[:, j:j + S]
    return out


def _rg_lru(x, w_a, b_a, w_x, b_x, lam_p):
    B, S, C = x.shape
    xb = x.reshape(B, S, RNN_BLOCKS, RNN_BLOCK_DIM)
    r = jax.nn.sigmoid((jnp.einsum('bsnc,ncd->bsnd', xb, w_a) + b_a).astype(jnp.float32)).reshape(B, S, C)
    i = jax.nn.sigmoid((jnp.einsum('bsnc,ncd->bsnd', xb, w_x) + b_x).astype(jnp.float32)).reshape(B, S, C)
    log_a = -LRU_C * r * jax.nn.softplus(-lam_p.astype(jnp.float32))
    a = jnp.exp(log_a)
    u = jnp.sqrt(-jnp.expm1(2.0 * log_a)) * i * x.astype(jnp.float32)

    def comb(left, right):
        a1, b1 = left
        a2, b2 = right
        return a1 * a2, a2 * b1 + b2

    _, h = lax.associative_scan(comb, (a, u), axis=1)
    return h.astype(x.dtype)


def setup_inputs(seed: int = 0) -> dict:
    key = jax.random.key(seed)
    ks = jax.random.split(key, 20)
    beta = (8.0 * DEPTH) ** -0.25
    nrm = lambda k, shape, s: jax.random.normal(k, shape, jnp.float32) * s
    x = jax.random.normal(ks[0], (BATCH, SEQ, D_MODEL), jnp.float32)
    w_in = nrm(ks[1], (DEPTH, D_MODEL, IN_WIDTH), D_MODEL ** -0.5)
    v0, v1 = IN_SPLITS[1], IN_SPLITS[2]
    w_in = w_in.at[:, :, v0:v1].multiply(beta)
    lam_q1 = nrm(ks[2], (DEPTH, ATTN_HEAD_DIM), 0.1)
    lam_k1 = nrm(ks[3], (DEPTH, ATTN_HEAD_DIM), 0.1)
    lam_q2 = nrm(ks[4], (DEPTH, ATTN_HEAD_DIM), 0.1)
    lam_k2 = nrm(ks[5], (DEPTH, ATTN_HEAD_DIM), 0.1)
    subln_g = 1.0 + nrm(ks[6], (DEPTH, ATTN_V_DIM), 0.02)
    conv_w = nrm(ks[7], (DEPTH, CONV_WIDTH, RNN_WIDTH), CONV_WIDTH ** -0.5)
    conv_b = nrm(ks[8], (DEPTH, RNN_WIDTH), 0.01)
    w_a = nrm(ks[9], (DEPTH, RNN_BLOCKS, RNN_BLOCK_DIM, RNN_BLOCK_DIM), RNN_BLOCK_DIM ** -0.5)
    b_a = nrm(ks[10], (DEPTH, RNN_BLOCKS, RNN_BLOCK_DIM), 0.01)
    w_x = nrm(ks[11], (DEPTH, RNN_BLOCKS, RNN_BLOCK_DIM, RNN_BLOCK_DIM), RNN_BLOCK_DIM ** -0.5)
    b_x = nrm(ks[12], (DEPTH, RNN_BLOCKS, RNN_BLOCK_DIM), 0.01)
    a_c = jax.random.uniform(ks[13], (DEPTH, RNN_WIDTH), jnp.float32, 0.9, 0.999)
    a0 = a_c ** (1.0 / LRU_C)
    lru_lambda = jnp.log(a0) - jnp.log1p(-a0)
    merge_b = nrm(ks[14], (DEPTH, 2 * D_MODEL), 0.01)
    w_attn_proj = nrm(ks[15], (DEPTH, ATTN_WIDTH, D_MODEL), ATTN_WIDTH ** -0.5 * beta)
    w_rnn_proj = nrm(ks[16], (DEPTH, RNN_WIDTH, D_MODEL), RNN_WIDTH ** -0.5 * beta)
    w_out = nrm(ks[17], (DEPTH, D_MODEL, D_MODEL), D_MODEL ** -0.5 * beta)
    ln_g = 1.0 + nrm(ks[18], (DEPTH, D_MODEL), 0.02)
    ln_b = nrm(ks[19], (DEPTH, D_MODEL), 0.01)
    return {"x": x, "w_in": w_in, "lam_q1": lam_q1, "lam_k1": lam_k1, "lam_q2": lam_q2,
            "lam_k2": lam_k2, "subln_g": subln_g, "conv_w": conv_w, "conv_b": conv_b,
            "w_a": w_a, "b_a": b_a, "w_x": w_x, "b_x": b_x, "lru_lambda": lru_lambda,
            "merge_b": merge_b, "w_attn_proj": w_attn_proj, "w_rnn_proj": w_rnn_proj,
            "w_out": w_out, "ln_g": ln_g, "ln_b": ln_b}


def reference(x, w_in, lam_q1, lam_k1, lam_q2, lam_k2, subln_g, conv_w, conv_b, w_a, b_a,
              w_x, b_x, lru_lambda, merge_b, w_attn_proj, w_rnn_proj, w_out, ln_g, ln_b):
    B, S, _ = x.shape
    pos = jnp.arange(S)
    alpha = (2.0 * DEPTH) ** 0.25
    for l in range(DEPTH):
        lambda_init = 0.8 - 0.6 * math.exp(-0.3 * l)
        proj = jnp.einsum('bsd,de->bse', x, w_in[l])
        q, k, v, g_att, x_rnn, g_rnn, m_att, m_rnn = jnp.split(proj, IN_SPLITS, axis=-1)

        q = _rope_partial(q.reshape(B, S, ATTN_HEADS, 2, ATTN_HEAD_DIM), pos)
        k = _rope_partial(k.reshape(B, S, ATTN_HEADS, 2, ATTN_HEAD_DIM), pos)
        v = v.reshape(B, S, ATTN_HEADS, ATTN_V_DIM)
        lam = (jnp.exp(jnp.sum(lam_q1[l].astype(jnp.float32) * lam_k1[l].astype(jnp.float32)))
               - jnp.exp(jnp.sum(lam_q2[l].astype(jnp.float32) * lam_k2[l].astype(jnp.float32)))
               + lambda_init)
        o = _diff_attention(q, k, v, lam).astype(jnp.float32)
        o = o * lax.rsqrt(jnp.mean(o * o, axis=-1, keepdims=True) + SUBLN_EPS)
        o = (o * subln_g[l].astype(jnp.float32) * (1.0 - lambda_init)).astype(x.dtype)
        o = o.reshape(B, S, ATTN_WIDTH) * jax.nn.silu(g_att)
        y_att = jnp.einsum('bse,ed->bsd', o, w_attn_proj[l])

        xc = _causal_conv(x_rnn, conv_w[l], conv_b[l])
        h = _rg_lru(xc, w_a[l], b_a[l], w_x[l], b_x[l], lru_lambda[l])
        y_rnn = jnp.einsum('bse,ed->bsd', h * jax.nn.silu(g_rnn), w_rnn_proj[l])

        gates = jax.nn.sigmoid(jnp.concatenate([m_att, m_rnn], -1) + merge_b[l])
        merged = gates[..., :D_MODEL] * y_att + gates[..., D_MODEL:] * y_rnn
        out = jnp.einsum('bsd,de->bse', merged, w_out[l])

        y = (alpha * x + out).astype(jnp.float32)
        mu = jnp.mean(y, axis=-1, keepdims=True)
        var = jnp.mean(jnp.square(y - mu), axis=-1, keepdims=True)
        y = (y - mu) * lax.rsqrt(var + LN_EPS) * ln_g[l].astype(jnp.float32) + ln_b[l].astype(jnp.float32)
        x = y.astype(x.dtype)
    return x
```

```cpp
#include <hip/hip_runtime.h>
#include <cstdio>
#include <cstdint>
namespace pg8 {
#define PG8_LAS __attribute__((address_space(3)))
typedef unsigned short bf16_t;
typedef short bf16x8 __attribute__((ext_vector_type(8)));
typedef float f32x4 __attribute__((ext_vector_type(4)));
typedef unsigned u32x4 __attribute__((ext_vector_type(4)));
constexpr int BM = 256, BK = 64, HALF = 128, HTB = HALF * BK * 2  , STAGE_BYTES = 8 * HTB, NXCD = 8, WGM = 8;

__host__ __device__ __forceinline__ int lds_byte(int r, int c) { const int st = (r >> 4) * 2 + (c >> 5), rr = r & 15, cc = c & 31, ob = rr * 64 + cc * 2; return st * 1024 + (ob ^ (((ob >> 9) & 1) << 5)); }
__host__ __device__ __forceinline__ void stage_rc(int b, int& R, int& C) { const int st = b / 1024, sb = b % 1024, swz = sb ^ (((sb >> 9) & 1) << 5); R = (st >> 1) * 16 + swz / 64; C = (st & 1) * 32 + (swz % 64) / 2; }
__host__ __device__ __forceinline__ int perm32(int rho) { const int n = rho >> 4, i = rho & 15; return 8 * (i >> 2) + 4 * n + (i & 3); }

struct Unit { int pm, pn, seg; };
struct Gemm { const bf16_t* A; const bf16_t* Bt; int M, N, K; const bf16_t* A2; const bf16_t* Bt2; };

struct StaticOrder {
    int nM, nN, nwg, G, c;
    __host__ __device__ void init(int M, int N, int G_, int c_) { nM = M / BM; nN = N / BM; nwg = nM * nN; G = G_; c = c_; }
    __host__ __device__ bool next(int i, Unit& u) const {
        const long L = (long)i * G + c; if (L >= nwg) return false;
        int wgid = (int)L; { const int q = nwg / NXCD, r = nwg % NXCD, xcd = wgid % NXCD, off = wgid / NXCD; wgid = (xcd < r ? xcd * (q + 1) : r * (q + 1) + (xcd - r) * q) + off; }
        const int nig = WGM * nN, gid = wgid / nig, fm = gid * WGM, gsz = (nM - fm) < WGM ? (nM - fm) : WGM;
        u.pm = fm + ((wgid % nig) % gsz); u.pn = (wgid % nig) / gsz; u.seg = 0; return true;
    }
    __device__ __forceinline__ void a_ready(const Unit&) const {}
    __device__ __forceinline__ void done(const Unit&) const {}
};

__device__ __forceinline__ unsigned cvt_pk_bf16(float lo, float hi) { unsigned r; asm volatile("v_cvt_pk_bf16_f32 %0, %1, %2" : "=v"(r) : "v"(lo), "v"(hi)); return r; }
typedef float f32x2 __attribute__((ext_vector_type(2)));
__device__ __forceinline__ f32x2 gelu_pk(f32x2 v) {
    const f32x2 av = __builtin_elementwise_abs(v), d = av * 0.2316418882f + 1.0f;
    f32x2 t; t.x = __builtin_amdgcn_rcpf(d.x); t.y = __builtin_amdgcn_rcpf(d.y);
    f32x2 q = t * 0.5307027145f + (-0.7265760135f); q = q * t + 0.7107068705f; q = q * t + (-0.142248368f); q = q * t + 0.127414796f; q = q * t;
    const f32x2 s = (v * v) * (-0.72134752044f);
    f32x2 e; e.x = __builtin_amdgcn_exp2f(s.x); e.y = __builtin_amdgcn_exp2f(s.y);
    const f32x2 m = v * (q * e), r = v - m;
    f32x2 o; o.x = v.x < 0.f ? m.x : r.x; o.y = v.y < 0.f ? m.y : r.y; return o;
}

template <int ACT  > struct EpiBf16 {
    static constexpr bool PERM = true, AFTER_DRAIN = false; static_assert(ACT == 0 || ACT == 1, "EpiBf16: ACT is 0 (none) or 1 (gelu_pk)");
    bf16_t* O; int ldc; const float* bias; int split_cols; size_t split_stride; float scale0;
    __device__ __forceinline__ void operator()(const f32x4 (&acc)[2][2][4][2], const Unit& u, int wr, int wc, int fr, int fq) const {
        const int row0 = u.pm * BM + wr * 64 + fr; int colt = u.pn * BM; bf16_t* base = O;
        float sc = 1.f; if (split_cols) { const int t = colt / split_cols; base += (size_t)t * split_stride; colt -= t * split_cols; if (t == 0) sc = scale0; }
        const int col0 = colt + wc * 32 + 8 * fq, bcol0 = u.pn * BM + wc * 32 + 8 * fq;
        f32x4 bv[2][2];
#pragma unroll
        for (int bj = 0; bj < 2; ++bj)
#pragma unroll
            for (int n = 0; n < 2; ++n) bv[bj][n] = bias ? *(const f32x4*)(bias + bcol0 + bj * HALF + 4 * n) : (f32x4){0.f, 0.f, 0.f, 0.f};
#pragma unroll
        for (int ai = 0; ai < 2; ++ai)
#pragma unroll
            for (int m = 0; m < 4; ++m) { bf16_t* rowp = base + (size_t)(row0 + ai * HALF + m * 16) * ldc + col0;
#pragma unroll
                for (int bj = 0; bj < 2; ++bj) { f32x4 v0 = acc[ai][bj][m][0] + bv[bj][0], v1 = acc[ai][bj][m][1] + bv[bj][1];
                    if (ACT == 1) { f32x2 a = gelu_pk((f32x2){v0[0], v0[1]}), b = gelu_pk((f32x2){v0[2], v0[3]}), c = gelu_pk((f32x2){v1[0], v1[1]}), d = gelu_pk((f32x2){v1[2], v1[3]});
                        v0 = (f32x4){a.x, a.y, b.x, b.y}; v1 = (f32x4){c.x, c.y, d.x, d.y}; }
                    v0 = v0 * sc; v1 = v1 * sc; u32x4 w; w.x = cvt_pk_bf16(v0[0], v0[1]); w.y = cvt_pk_bf16(v0[2], v0[3]); w.z = cvt_pk_bf16(v1[0], v1[1]); w.w = cvt_pk_bf16(v1[2], v1[3]);
                    *(u32x4*)(rowp + bj * HALF) = w; } }
    }
};

__device__ __forceinline__ float bf_lo(unsigned w) { return __builtin_bit_cast(float, w << 16); }
__device__ __forceinline__ float bf_hi(unsigned w) { return __builtin_bit_cast(float, w & 0xffff0000u); }
struct EpiProj {
    static constexpr bool PERM = true, AFTER_DRAIN = false;
    bf16_t *d0, *d1, *d2, *d3, *d4, *d5, *d6, *d7; const float* rope; float qscale; int seqmask;
    __device__ __forceinline__ void operator()(f32x4 (&acc)[2][2][4][2], const Unit& u, int wr, int wc, int fr, int fq) const {
        const int grp = u.pn >> 2;
        bf16_t* base = grp == 0 ? d0 : grp == 1 ? d1 : grp == 2 ? d2 : grp == 3 ? d3 : grp == 4 ? d4 : grp == 5 ? d5 : grp == 6 ? d6 : d7;
        const int row0 = u.pm * BM + wr * 64 + fr, col0 = (u.pn & 3) * BM + wc * 32 + 8 * fq;
        const bool rot = (grp < 2) && ((wc & 1) == 0);
        const float sc = (grp == 0) ? qscale : 1.f;
#pragma unroll
        for (int ai = 0; ai < 2; ++ai)
#pragma unroll
            for (int m = 0; m < 4; ++m) {
                const int row = row0 + ai * HALF + m * 16;
                f32x4 cs0 = {1.f, 1.f, 1.f, 1.f}, cs1 = cs0, sn0 = {0.f, 0.f, 0.f, 0.f}, sn1 = sn0;
                if (rot) { const float* rp = rope + (size_t)(row & seqmask) * 16; cs0 = *(const f32x4*)(rp); cs1 = *(const f32x4*)(rp + 4); sn0 = *(const f32x4*)(rp + 8); sn1 = *(const f32x4*)(rp + 12);
                    if (fq == 0) { sn0 = -sn0; sn1 = -sn1; } if (fq >= 2) { sn0 = (f32x4){0.f, 0.f, 0.f, 0.f}; sn1 = sn0; cs0 = (f32x4){1.f, 1.f, 1.f, 1.f}; cs1 = cs0; } }
                bf16_t* rowp = base + (size_t)row * 1024 + col0;
#pragma unroll
                for (int bj = 0; bj < 2; ++bj) {
                    f32x4 v0 = acc[ai][bj][m][0], v1 = acc[ai][bj][m][1];
                    if (rot) { f32x4 p0, p1;
#pragma unroll
                        for (int e = 0; e < 4; ++e) { p0[e] = __shfl_xor(v0[e], 16); p1[e] = __shfl_xor(v1[e], 16); }
                        v0 = v0 * cs0 + p0 * sn0; v1 = v1 * cs1 + p1 * sn1; }
                    v0 = v0 * sc; v1 = v1 * sc;
                    u32x4 w; w.x = cvt_pk_bf16(v0[0], v0[1]); w.y = cvt_pk_bf16(v0[2], v0[3]); w.z = cvt_pk_bf16(v1[0], v1[1]); w.w = cvt_pk_bf16(v1[2], v1[3]);
                    *(u32x4*)(rowp + bj * HALF) = w; }
            }
    }
};
struct EpiMerge {
    static constexpr bool PERM = true, AFTER_DRAIN = false;
    const bf16_t* matt; const bf16_t* mrnn; const float* mb; bf16_t* O;
    __device__ __forceinline__ void operator()(f32x4 (&acc)[2][2][4][2], const Unit& u, int wr, int wc, int fr, int fq) const {
        const int row0 = u.pm * BM + wr * 64 + fr, col0 = u.pn * BM + wc * 32 + 8 * fq;
#pragma unroll
        for (int bj = 0; bj < 2; ++bj) {
            const int col = col0 + bj * HALF;
            const f32x4 br0 = *(const f32x4*)(mb + 1024 + col), br1 = *(const f32x4*)(mb + 1024 + col + 4);
            const f32x4 ba0 = *(const f32x4*)(mb + col), ba1 = *(const f32x4*)(mb + col + 4);
#pragma unroll
            for (int ai = 0; ai < 2; ++ai)
#pragma unroll
                for (int m = 0; m < 4; ++m) {
                    const size_t off = (size_t)(row0 + ai * HALF + m * 16) * 1024 + col;
                    const u32x4 wr_ = *(const u32x4*)(mrnn + off);
                    float er[8];
                    er[0] = __expf(-(bf_lo(wr_.x) + br0[0])); er[1] = __expf(-(bf_hi(wr_.x) + br0[1])); er[2] = __expf(-(bf_lo(wr_.y) + br0[2])); er[3] = __expf(-(bf_hi(wr_.y) + br0[3]));
                    er[4] = __expf(-(bf_lo(wr_.z) + br1[0])); er[5] = __expf(-(bf_hi(wr_.z) + br1[1])); er[6] = __expf(-(bf_lo(wr_.w) + br1[2])); er[7] = __expf(-(bf_hi(wr_.w) + br1[3]));
                    f32x4 v0 = acc[ai][bj][m][0], v1 = acc[ai][bj][m][1];
                    if (u.seg == 0) {
                        const u32x4 wa_ = *(const u32x4*)(matt + off);
                        float ea[8];
                        ea[0] = __expf(-(bf_lo(wa_.x) + ba0[0])); ea[1] = __expf(-(bf_hi(wa_.x) + ba0[1])); ea[2] = __expf(-(bf_lo(wa_.y) + ba0[2])); ea[3] = __expf(-(bf_hi(wa_.y) + ba0[3]));
                        ea[4] = __expf(-(bf_lo(wa_.z) + ba1[0])); ea[5] = __expf(-(bf_hi(wa_.z) + ba1[1])); ea[6] = __expf(-(bf_lo(wa_.w) + ba1[2])); ea[7] = __expf(-(bf_hi(wa_.w) + ba1[3]));
#pragma unroll
                        for (int e = 0; e < 4; ++e) { v0[e] *= (1.f + er[e]) / (1.f + ea[e]); v1[e] *= (1.f + er[4 + e]) / (1.f + ea[4 + e]); }
                        acc[ai][bj][m][0] = v0; acc[ai][bj][m][1] = v1;
                    } else {
#pragma unroll
                        for (int e = 0; e < 4; ++e) { v0[e] = v0[e] / (1.f + er[e]); v1[e] = v1[e] / (1.f + er[4 + e]); }
                        u32x4 w; w.x = cvt_pk_bf16(v0[0], v0[1]); w.y = cvt_pk_bf16(v0[2], v0[3]); w.z = cvt_pk_bf16(v1[0], v1[1]); w.w = cvt_pk_bf16(v1[2], v1[3]);
                        *(u32x4*)(O + off) = w;
                    }
                }
        }
    }
};
struct EpiResF32 {
    static constexpr bool PERM = false, AFTER_DRAIN = false;
    const float* x; float* out; float alpha;
    __device__ __forceinline__ void operator()(f32x4 (&acc)[2][2][4][2], const Unit& u, int wr, int wc, int fr, int fq) const {
        const int col0 = u.pn * BM + wc * 32 + 4 * fq;
#pragma unroll
        for (int ai = 0; ai < 2; ++ai)
#pragma unroll
            for (int m = 0; m < 4; ++m) { const size_t off = (size_t)(u.pm * BM + ai * HALF + wr * 64 + m * 16 + fr) * 1024 + col0;
#pragma unroll
                for (int bj = 0; bj < 2; ++bj)
#pragma unroll
                    for (int n = 0; n < 2; ++n) { const f32x4 xv = *(const f32x4*)(x + off + bj * HALF + n * 16); *(f32x4*)(out + off + bj * HALF + n * 16) = xv * alpha + acc[ai][bj][m][n]; } }
    }
};
struct DualOrder {
    StaticOrder so;
    __host__ __device__ void init(int M, int N, int G_, int c_) { so.init(M, N, G_, c_); }
    __host__ __device__ bool next(int i, Unit& u) const { if (!so.next(i >> 1, u)) return false; u.seg = i & 1; return true; }
    __device__ __forceinline__ void a_ready(const Unit&) const {}
    __device__ __forceinline__ void done(const Unit&) const {}
};


template <class Epi, class Sched, bool ALIGN_EPI = false, bool SP2 = false>
__device__ __forceinline__ void gemm_phase(PG8_LAS unsigned char* lds, const Gemm g, const Sched& S, const Epi& E) {
    int tid = threadIdx.x; asm volatile("" : "+v"(tid));
    const int wid = __builtin_amdgcn_readfirstlane(tid >> 6), lane = tid & 63, wr = wid >> 2, wc = wid & 3, fr = lane & 15, fq = lane >> 4;
    const int K = g.K, nt = K / BK;
    unsigned voffA[2], voffB[2];
#pragma unroll
    for (int i = 0; i < 2; ++i) { int R, C; stage_rc(tid * 16 + i * 8192, R, C); const int Rb = Epi::PERM ? ((R & ~31) + perm32(R & 31)) : R;
        voffA[i] = (unsigned)(R * K + C) * 2u; voffB[i] = (unsigned)(Rb * K + C) * 2u; }
    const size_t kstep = (size_t)(BK * 2);
    const size_t hstep = (size_t)HALF * K * 2;
    const size_t tstep = 2 * hstep;
    const unsigned ldsw = (unsigned)wid * 1024u;
    const int aoff = lds_byte(wr * 64 + fr, fq * 8), boff = lds_byte(wc * 32 + fr, fq * 8);
#define PG8_SA(b, h) (((b) * 2 + (h)) * HTB)
#define PG8_SB(b, h) ((4 + (b) * 2 + (h)) * HTB)
#define PG8_STAGE(bufoff, gbase, voff) do { _Pragma("unroll") for (int _i = 0; _i < 2; ++_i) \
        __builtin_amdgcn_global_load_lds((const unsigned*)((const char*)(gbase) + (voff)[_i]), (PG8_LAS unsigned*)(lds + (bufoff) + ldsw + _i * 8192), 16, 0, 0); } while (0)
#define PG8_LDA(dst, b, h) do { _Pragma("unroll") for (int m = 0; m < 4; ++m) _Pragma("unroll") for (int k = 0; k < 2; ++k) dst[m][k] = *(const PG8_LAS bf16x8*)(lds + PG8_SA(b, h) + aoff + m * 2048 + k * 1024); } while (0)
#define PG8_LDB(dst, b, h) do { _Pragma("unroll") for (int n = 0; n < 2; ++n) _Pragma("unroll") for (int k = 0; k < 2; ++k) dst[n][k] = *(const PG8_LAS bf16x8*)(lds + PG8_SB(b, h) + boff + n * 2048 + k * 1024); } while (0)
#define PG8_MMA(ai, bj, At, Bt) do { __builtin_amdgcn_s_setprio(1); _Pragma("unroll") for (int m = 0; m < 4; ++m) _Pragma("unroll") for (int n = 0; n < 2; ++n) _Pragma("unroll") for (int k = 0; k < 2; ++k) \
        acc[ai][bj][m][n] = __builtin_amdgcn_mfma_f32_16x16x32_bf16(Bt[n][k], At[m][k], acc[ai][bj][m][n], 0, 0, 0); __builtin_amdgcn_s_setprio(0); } while (0)
#define PG8_WAIT_V(n) asm volatile("s_waitcnt vmcnt(" #n ")" ::: "memory")
#define PG8_WAIT_L(n) asm volatile("s_waitcnt lgkmcnt(" #n ")" ::: "memory")
#define PG8_BAR __builtin_amdgcn_s_barrier()
#define PG8_SCHED __builtin_amdgcn_sched_barrier(0)
    Unit cur, nxt; int ui = 0;
    if (!S.next(0, cur)) return;
    f32x4 acc[2][2][4][2];
#pragma unroll
    for (int a = 0; a < 2; ++a)
#pragma unroll
        for (int b = 0; b < 2; ++b)
#pragma unroll
            for (int m = 0; m < 4; ++m)
#pragma unroll
                for (int n = 0; n < 2; ++n) acc[a][b][m][n] = (f32x4){0.f, 0.f, 0.f, 0.f};
    bf16x8 At[4][2], B0[2][2], B1[2][2];
    const char* cA = (const char*)(cur.seg ? g.A2 : g.A) + (size_t)cur.pm * tstep; const char* cB = (const char*)(cur.seg ? g.Bt2 : g.Bt) + (size_t)cur.pn * tstep;
    S.a_ready(cur);
    if constexpr (SP2) {
        PG8_STAGE(PG8_SB(0, 0), cB, voffB); PG8_STAGE(PG8_SB(0, 1), cB + hstep, voffB); PG8_STAGE(PG8_SA(0, 0), cA, voffA); PG8_STAGE(PG8_SA(0, 1), cA + hstep, voffA);
        if (wr == 1) PG8_BAR;
        PG8_WAIT_V(2); PG8_BAR;
        PG8_STAGE(PG8_SB(1, 0), cB + kstep, voffB); PG8_STAGE(PG8_SA(1, 0), cA + kstep, voffA); PG8_STAGE(PG8_SB(1, 1), cB + hstep + kstep, voffB);
        PG8_WAIT_V(6); PG8_BAR;
    } else {
        PG8_STAGE(PG8_SB(0, 0), cB, voffB); PG8_STAGE(PG8_SA(0, 0), cA, voffA); PG8_STAGE(PG8_SB(0, 1), cB + hstep, voffB); PG8_STAGE(PG8_SA(0, 1), cA + hstep, voffA);
        if (wr == 1) PG8_BAR;
        PG8_WAIT_V(4); PG8_BAR;
        PG8_STAGE(PG8_SB(1, 0), cB + kstep, voffB); PG8_STAGE(PG8_SA(1, 0), cA + kstep, voffA); PG8_STAGE(PG8_SB(1, 1), cB + hstep + kstep, voffB);
        PG8_WAIT_V(6); PG8_BAR;
    }
    for (;;) {
        const bool has_next = S.next(ui + 1, nxt);
        const char* nA = has_next ? (const char*)(nxt.seg ? g.A2 : g.A) + (size_t)nxt.pm * tstep : cA; const char* nB = has_next ? (const char*)(nxt.seg ? g.Bt2 : g.Bt) + (size_t)nxt.pn * tstep : cB;
        for (int t = 0; t < nt; t += 2) {
            const bool last = (t == nt - 2);
            const char* a1 = cA + (size_t)(t + 1) * kstep;
            const char* a2 = last ? nA : cA + (size_t)(t + 2) * kstep; const char* b2 = last ? nB : cB + (size_t)(t + 2) * kstep;
            const char* a3 = a2 + kstep; const char* b3 = b2 + kstep;
            if (last && has_next) S.a_ready(nxt);
            if constexpr (SP2) {
            PG8_LDB(B0, 0, 0); PG8_LDB(B1, 0, 1); PG8_SCHED; PG8_LDA(At, 0, 0); PG8_STAGE(PG8_SA(1, 1), a1 + hstep, voffA);
            PG8_WAIT_V(8); PG8_WAIT_L(0); PG8_BAR; PG8_MMA(0, 0, At, B0); PG8_MMA(0, 1, At, B1); PG8_BAR; PG8_SCHED;
            PG8_LDA(At, 0, 1); PG8_STAGE(PG8_SB(0, 0), b2, voffB); PG8_STAGE(PG8_SB(0, 1), b2 + hstep, voffB); PG8_STAGE(PG8_SA(0, 0), a2, voffA);
            PG8_WAIT_V(8); PG8_WAIT_L(0); PG8_BAR; PG8_MMA(1, 0, At, B0); PG8_MMA(1, 1, At, B1); PG8_BAR; PG8_SCHED;
            PG8_LDB(B0, 1, 0); PG8_LDB(B1, 1, 1); PG8_SCHED; PG8_LDA(At, 1, 0); PG8_STAGE(PG8_SA(0, 1), a2 + hstep, voffA);
            PG8_WAIT_V(8); PG8_WAIT_L(0); PG8_BAR; PG8_MMA(0, 0, At, B0); PG8_MMA(0, 1, At, B1); PG8_BAR; PG8_SCHED;
            PG8_LDA(At, 1, 1); PG8_STAGE(PG8_SB(1, 0), b3, voffB); PG8_STAGE(PG8_SB(1, 1), b3 + hstep, voffB); PG8_STAGE(PG8_SA(1, 0), a3, voffA);
            PG8_WAIT_V(8); PG8_WAIT_L(0); PG8_BAR; PG8_MMA(1, 0, At, B0); PG8_MMA(1, 1, At, B1); PG8_BAR; PG8_SCHED;
            } else {
            PG8_LDB(B0, 0, 0); PG8_SCHED; PG8_LDA(At, 0, 0); PG8_STAGE(PG8_SA(1, 1), a1 + hstep, voffA);
            PG8_WAIT_L(8); PG8_BAR; PG8_WAIT_L(0); PG8_MMA(0, 0, At, B0); PG8_BAR; PG8_SCHED;
            PG8_LDB(B1, 0, 1); PG8_STAGE(PG8_SB(0, 0), b2, voffB);
            PG8_BAR; PG8_WAIT_L(0); PG8_MMA(0, 1, At, B1); PG8_BAR;
            PG8_LDA(At, 0, 1); PG8_STAGE(PG8_SA(0, 0), a2, voffA);
            PG8_BAR; PG8_WAIT_L(0); PG8_MMA(1, 0, At, B0); PG8_BAR; PG8_SCHED;
            PG8_STAGE(PG8_SB(0, 1), b2 + hstep, voffB);
            PG8_WAIT_V(6); PG8_BAR; PG8_MMA(1, 1, At, B1); PG8_BAR;
            PG8_LDB(B0, 1, 0); PG8_SCHED; PG8_LDA(At, 1, 0); PG8_STAGE(PG8_SA(0, 1), a2 + hstep, voffA);
            PG8_WAIT_L(8); PG8_BAR; PG8_WAIT_L(0); PG8_MMA(0, 0, At, B0); PG8_BAR; PG8_SCHED;
            PG8_LDB(B1, 1, 1); PG8_STAGE(PG8_SB(1, 0), b3, voffB);
            PG8_BAR; PG8_WAIT_L(0); PG8_MMA(0, 1, At, B1); PG8_BAR;
            PG8_LDA(At, 1, 1); PG8_STAGE(PG8_SA(1, 0), a3, voffA);
            PG8_BAR; PG8_WAIT_L(0); PG8_MMA(1, 0, At, B0); PG8_BAR; PG8_SCHED;
            PG8_STAGE(PG8_SB(1, 1), b3 + hstep, voffB);
            PG8_WAIT_V(6); PG8_BAR; PG8_MMA(1, 1, At, B1); PG8_BAR;
            }
        }
        if constexpr (ALIGN_EPI) { if (wr == 0) PG8_BAR; }
        if constexpr (!Epi::AFTER_DRAIN) { E(acc, cur, wr, wc, fr, fq); S.done(cur); }
        if (!has_next) break;
        if (nxt.seg == 0) {
#pragma unroll
        for (int a = 0; a < 2; ++a)
#pragma unroll
            for (int b = 0; b < 2; ++b)
#pragma unroll
                for (int m = 0; m < 4; ++m)
#pragma unroll
                    for (int n = 0; n < 2; ++n) acc[a][b][m][n] = (f32x4){0.f, 0.f, 0.f, 0.f};
        }
        cur = nxt; cA = nA; cB = nB; ++ui;
        if constexpr (ALIGN_EPI) { if (wr == 1) PG8_BAR; }
    }
    PG8_WAIT_V(0);
    if constexpr (!ALIGN_EPI) { if (wr == 0) PG8_BAR; }
    PG8_BAR;
    if constexpr (Epi::AFTER_DRAIN) { E.fused(acc, cur, wr, wc, fr, fq, lds, wid, lane); S.done(cur); }
#undef PG8_SA
#undef PG8_SB
#undef PG8_STAGE
#undef PG8_LDA
#undef PG8_LDB
#undef PG8_MMA
#undef PG8_WAIT_V
#undef PG8_WAIT_L
#undef PG8_BAR
#undef PG8_SCHED
}
}

#ifndef PG8_SP2
#define PG8_SP2 true
#endif
#ifndef PG8_ALIGN
#define PG8_ALIGN true
#endif
#include <hip/hip_bf16.h>
#include <cmath>
namespace attn_body {
using bf16=__hip_bfloat16;
using bf16x8=__attribute__((ext_vector_type(8)))short;
using s16x4=__attribute__((ext_vector_type(4)))short;
using f32x16=__attribute__((ext_vector_type(16)))float;
using u32x4=__attribute__((ext_vector_type(4)))unsigned;
constexpr int BATCH=8,NHEAD=8,SEQ=4096,D=64,DM=1024;
constexpr int NW=8,QBLK=32,QB=QBLK*NW,KVBLK=64,NQB=SEQ/QB;
constexpr int ATTN_PITCH=DM, ATTN_UNIT_ROWS=QB;
__device__ __forceinline__ int crow(int r,int hi){return (r&3)+8*(r>>2)+4*hi;}
#define SBAR() __builtin_amdgcn_sched_barrier(0)
__device__ __forceinline__ void cmask(f32x16&p0,f32x16&p1,int jb,int qrel,int hi){
  const float NEG=-INFINITY; int kb=64*jb+4*hi;
  #pragma unroll
  for(int r=0;r<16;++r){int kv=kb+(r&3)+8*(r>>2); if(kv>qrel)p0[r]=NEG; if(kv+32>qrel)p1[r]=NEG;}
}

constexpr int NSLOT=3, SLOTB=8192;
constexpr int LDS_K=0, LDS_V=NSLOT*SLOTB, LDS_WS=2*NSLOT*SLOTB, LDS_OST=LDS_WS+NW*64*4, LDS_BYTES=LDS_OST+NW*4096;
constexpr float C2=0.125f*1.4426950408889634f;
__device__ __forceinline__ void glds16(const void*gsrc,unsigned lds_dst){unsigned keep;
  asm volatile("s_mov_b32 %0, m0\n\ts_mov_b32 m0, %2\n\ts_nop 0\n\tglobal_load_lds_dwordx4 %1, off\n\ts_mov_b32 m0, %0":"=&s"(keep):"v"(gsrc),"s"(lds_dst):"memory");}
__device__ __forceinline__ float max3f(float a,float b,float c){float r;asm("v_max3_f32 %0, %1, %2, %3":"=v"(r):"v"(a),"v"(b),"v"(c));return r;}
__device__ __forceinline__ float max2f(float a,float b){float r;asm("v_max_f32_e32 %0, %1, %2":"=v"(r):"v"(a),"v"(b));return r;}
__device__ __forceinline__ float fadd_s(float a,float b){float r;asm("v_add_f32_e32 %0, %1, %2":"=v"(r):"v"(a),"v"(b));return r;}
__device__ __forceinline__ float fsub_s(float a,float b){float r;asm("v_sub_f32_e32 %0, %1, %2":"=v"(r):"v"(a),"v"(b));return r;}
typedef float f32x2_t __attribute__((ext_vector_type(2))); typedef __bf16 bf16x2_t __attribute__((ext_vector_type(2)));
__device__ __forceinline__ unsigned cvtpk_s(float lo,float hi){f32x2_t v={lo,hi};bf16x2_t b=__builtin_convertvector(v,bf16x2_t);return __builtin_bit_cast(unsigned,b);}
#define WAIT_BAR(N) asm volatile("s_waitcnt vmcnt(" #N ") lgkmcnt(0)\n\ts_barrier":::"memory")

__device__ __forceinline__ void qkt(f32x16&p0,f32x16&p1,const char*Kslot,const bf16x8*qr,const f32x16&negm,int r32,int hi){
  const char*kb=Kslot+hi*1024+r32*16;
  #pragma unroll
  for(int d0=0;d0<4;++d0){
    const bf16x8 b0=*reinterpret_cast<const bf16x8*>(kb+d0*2048);
    const bf16x8 b1=*reinterpret_cast<const bf16x8*>(kb+d0*2048+512);
    if(d0==0){p0=__builtin_amdgcn_mfma_f32_32x32x16_bf16(b0,qr[0],negm,0,0,0);p1=__builtin_amdgcn_mfma_f32_32x32x16_bf16(b1,qr[0],negm,0,0,0);}
    else{p0=__builtin_amdgcn_mfma_f32_32x32x16_bf16(b0,qr[d0],p0,0,0,0);p1=__builtin_amdgcn_mfma_f32_32x32x16_bf16(b1,qr[d0],p1,0,0,0);}}
}
typedef __attribute__((address_space(3))) const char* lds_cptr;
typedef short v4i16_t __attribute__((ext_vector_type(4)));
__device__ __forceinline__ void kload8(bf16x8*kf,lds_cptr kp){
  kf[0]=*(const __attribute__((address_space(3))) bf16x8*)(kp);      kf[1]=*(const __attribute__((address_space(3))) bf16x8*)(kp+512);
  kf[2]=*(const __attribute__((address_space(3))) bf16x8*)(kp+2048); kf[3]=*(const __attribute__((address_space(3))) bf16x8*)(kp+2560);
  kf[4]=*(const __attribute__((address_space(3))) bf16x8*)(kp+4096); kf[5]=*(const __attribute__((address_space(3))) bf16x8*)(kp+4608);
  kf[6]=*(const __attribute__((address_space(3))) bf16x8*)(kp+6144); kf[7]=*(const __attribute__((address_space(3))) bf16x8*)(kp+6656);
}
__device__ __forceinline__ void kload2(bf16x8*kf,lds_cptr kp,int j){ kf[2*j]=*(const __attribute__((address_space(3))) bf16x8*)(kp+j*2048); kf[2*j+1]=*(const __attribute__((address_space(3))) bf16x8*)(kp+j*2048+512); }
__device__ __forceinline__ s16x4 vtr(lds_cptr p){ return __builtin_bit_cast(s16x4,__builtin_amdgcn_ds_read_tr16_b64_v4i16((__attribute__((address_space(3))) v4i16_t*)p)); }
__device__ __forceinline__ float rowmax(const f32x16&p0,const f32x16&p1){
  float a=max3f(p0[0],p0[1],p1[0]),b=max3f(p0[2],p0[3],p1[1]);a=max3f(a,p1[2],p1[3]);
  #pragma unroll
  for(int r=4;r<16;r+=4){a=max3f(a,p0[r],p0[r+1]);b=max3f(b,p0[r+2],p0[r+3]);a=max3f(a,p1[r],p1[r+1]);b=max3f(b,p1[r+2],p1[r+3]);}
  const float m=max2f(a,b);
  auto rr=__builtin_amdgcn_permlane32_swap(__float_as_uint(m),__float_as_uint(m),false,false);
  return max2f(__uint_as_float(rr[0]),__uint_as_float(rr[1]));
}
__device__ __forceinline__ void pv(f32x16*o,int vb,bf16x8 pa0,bf16x8 pa1,bf16x8 pa2,bf16x8 pa3){
  #pragma unroll
  for(int d0=0;d0<2;++d0){s16x4 lo[4],hi[4];
    #pragma unroll
    for(int ks=0;ks<4;++ks){
      asm volatile("ds_read_b64_tr_b16 %0,%1 offset:%c2":"=&v"(lo[ks]):"v"(vb),"i"(d0*4096+ks*1024):"memory");
      asm volatile("ds_read_b64_tr_b16 %0,%1 offset:%c2":"=&v"(hi[ks]):"v"(vb),"i"(d0*4096+ks*1024+512):"memory");}
    asm volatile("s_waitcnt lgkmcnt(0)":::"memory");SBAR();
    #define PK(k) (bf16x8){lo[k][0],lo[k][1],lo[k][2],lo[k][3],hi[k][0],hi[k][1],hi[k][2],hi[k][3]}
    o[d0]=__builtin_amdgcn_mfma_f32_32x32x16_bf16(pa0,PK(0),o[d0],0,0,0);
    o[d0]=__builtin_amdgcn_mfma_f32_32x32x16_bf16(pa1,PK(1),o[d0],0,0,0);
    o[d0]=__builtin_amdgcn_mfma_f32_32x32x16_bf16(pa2,PK(2),o[d0],0,0,0);
    o[d0]=__builtin_amdgcn_mfma_f32_32x32x16_bf16(pa3,PK(3),o[d0],0,0,0);
    #undef PK
  }
}

#ifndef ATTN_STORE16
#define ATTN_STORE16(p,v) (*(u32x4*)(p)=(v))
#endif
template<int THRL> __device__ __forceinline__ void attn_unit(int b,int h,int qb,int p,float lam,const bf16*Q,const bf16*__restrict__ K,const bf16*__restrict__ V,bf16*GO,const float*__restrict__ subg,float*stash,char*shm){
  int tid=threadIdx.x; asm volatile("":"+v"(tid)); const int lane=tid&63,r32=lane&31,hi=lane>>5; const int wid=__builtin_amdgcn_readfirstlane(tid>>6);
  const long rowbase=(long)b*SEQ; const int q0=qb*QB;
  const int qkcol=h*128+(p&1)*64, vcol=h*128+(p>>1)*64;
  const bf16*Qw=Q+(rowbase+q0+wid*QBLK)*DM+qkcol;
  const bf16*Kh=K+rowbase*DM+qkcol,*Vh=V+rowbase*DM+vcol;
  const unsigned lds0=(unsigned)(uintptr_t)shm;
  float*wsf=(float*)(shm+LDS_WS)+wid*64;
  const bf16*ksrc=Kh+(long)lane*DM+wid*8;
  const bf16*vsrc=Vh+(long)(16*(wid&3)+(lane>>2))*DM+(wid>>2)*32+(lane&3)*8;
  const unsigned kdst=lds0+LDS_K+wid*1024, vdst=lds0+LDS_V+wid*1024;
  #define DMA_K(t,slot) glds16(ksrc+(long)(t)*KVBLK*DM,(unsigned)__builtin_amdgcn_readfirstlane(kdst+(slot)))
  #define DMA_V(t,slot) glds16(vsrc+(long)(t)*KVBLK*DM,(unsigned)__builtin_amdgcn_readfirstlane(vdst+(slot)))
  const int vb0=(int)(lds0+LDS_V)+((lane>>4)&1)*32+(lane&3)*8+(4*hi+((lane&15)>>2))*64;
  const char*Kbase=shm+LDS_K; bf16x8 kf[8];
  const lds_cptr shm3=(lds_cptr)shm; const lds_cptr kp0=shm3+LDS_K+hi*1024+r32*16; const lds_cptr vp0=shm3+LDS_V+((lane>>4)&1)*32+(lane&3)*8+(4*hi+((lane&15)>>2))*64;
  const int NT=(q0+QB)/KVBLK;
  DMA_K(0,0);DMA_V(0,0);DMA_K(1,SLOTB);
  bf16x8 qr[4];
  #pragma unroll
  for(int d0=0;d0<4;++d0)qr[d0]=*reinterpret_cast<const bf16x8*>(&Qw[(long)r32*DM+d0*16+hi*8]);
  float mhat=0.f,l_reg=0.f;f32x16 o[2];o[0]=f32x16{};o[1]=f32x16{};f32x16 negm=f32x16{};asm volatile("":"+v"(negm));
  const int qrel=wid*QBLK+r32;
  #define CMASK(P0,P1,t) do{int jb_=(t)-(NT-4); if(jb_>=0)cmask(P0,P1,jb_,qrel,hi);}while(0)
  bool resc=false;
  #define START(P0,P1) do{ const float rm=rowmax(P0,P1); resc=false; \
    { const float dl=rm; mhat=fadd_s(mhat,dl); \
      _Pragma("unroll") for(int r=0;r<16;++r){P0[r]=fsub_s(P0[r],dl);P1[r]=fsub_s(P1[r],dl);} \
      _Pragma("unroll") for(int r=0;r<16;++r)negm[r]=-mhat; asm volatile("":"+v"(negm)); } \
    _Pragma("unroll") for(int r=0;r<16;++r)P0[r]=__builtin_amdgcn_exp2f(P0[r]); }while(0)
  #define RESC() do{ if(resc){ asm volatile("s_waitcnt lgkmcnt(0)":::"memory"); \
      _Pragma("unroll") for(int d_=0;d_<2;++d_) _Pragma("unroll") for(int r=0;r<16;++r)o[d_][r]*=wsf[crow(r,hi)]; } }while(0)
  f32x16 pA0,pA1,pB0,pB1;
  int sl_prev=0,sl_cur=0,sl_next=SLOTB;
  #define ROT() do{sl_prev=sl_cur;sl_cur=sl_next;sl_next=(sl_next==(NSLOT-1)*SLOTB)?0:sl_next+SLOTB;}while(0)
  DMA_K(2,2*SLOTB);
  WAIT_BAR(3);
  qkt(pA0,pA1,Kbase,qr,negm,r32,hi);asm volatile("s_nop 15\n\ts_nop 7":"+v"(pA0),"+v"(pA1));CMASK(pA0,pA1,0);
  START(pA0,pA1);
  _Pragma("unroll") for(int r=0;r<16;++r)pA1[r]=__builtin_amdgcn_exp2f(pA1[r]);
  WAIT_BAR(0);
  DMA_K(3,0);DMA_V(1,SLOTB);
  ROT();
  kload8(kf,kp0+sl_cur);
  WAIT_BAR(2);
  s16x4 vlo[8],vhi[8]; u32x4 pw0,pw1,pw2,pw3;
  #define PKW(P,B) cvtpk_s(P[B],P[B+1])
  #define PAF(k) __builtin_bit_cast(bf16x8,pw##k)
  #define VFR(i) (bf16x8){vlo[i][0],vlo[i][1],vlo[i][2],vlo[i][3],vhi[i][0],vhi[i][1],vhi[i][2],vhi[i][3]}
  #define PIN(x) asm volatile("":"+v"(x))
  #define MX3(a,b,c) __builtin_fmaxf(__builtin_fmaxf((a),(b)),(c))
  #define GAPA(MF,A0,A1,A2,A3,W0,W1,PW) do{ MF; sacc+=A0; sacc+=A1; sacc+=A2; sacc+=A3; PIN(sacc); W0; W1; PIN(PW); SBAR(); }while(0)
  #define EX(v) __builtin_amdgcn_exp2f(v)
  #define GAPB(MF,X,B) do{ MF; X[B]=EX(X[B]); X[B+1]=EX(X[B+1]); X[B+2]=EX(X[B+2]); X[B+3]=EX(X[B+3]); PIN(X); SBAR(); }while(0)
  #define VRD(i) do{ vlo[i]=vtr(vp_+(((i)>>2)*4096+((i)&3)*1024)); vhi[i]=vtr(vp_+(((i)>>2)*4096+((i)&3)*1024+512)); }while(0)
  #define KRD(G,j) do{ if(G){ kload2(kf,kp0+sl_next,j); SBAR(); } }while(0)
  #define STEP(C0,C1,P0,P1,t,GK,GV,GL) do{ SBAR(); \
    const lds_cptr vp_=vp0+sl_prev; \
    VRD(0); SBAR(); float sacc=(P0[0]+P0[1]); \
    GAPA(C0=__builtin_amdgcn_mfma_f32_32x32x16_bf16(kf[0],qr[0],negm,0,0,0), P0[2],P0[3],P0[4],P0[5],     pw0[0]=PKW(P0,0), pw0[1]=PKW(P0,2), pw0); \
    VRD(4); SBAR(); GAPA(C1=__builtin_amdgcn_mfma_f32_32x32x16_bf16(kf[1],qr[0],negm,0,0,0), P0[6],P0[7],P0[8],P0[9],     pw0[2]=PKW(P0,4), pw0[3]=PKW(P0,6), pw0); \
    VRD(1); SBAR(); GAPA(C0=__builtin_amdgcn_mfma_f32_32x32x16_bf16(kf[2],qr[1],C0,0,0,0),   P0[10],P0[11],P0[12],P0[13], pw1[0]=PKW(P0,8), pw1[1]=PKW(P0,10), pw1); \
    VRD(5); SBAR(); GAPA(C1=__builtin_amdgcn_mfma_f32_32x32x16_bf16(kf[3],qr[1],C1,0,0,0),   P0[14],P0[15],P1[0],P1[1],   pw1[2]=PKW(P0,12),pw1[3]=PKW(P0,14), pw1); \
    VRD(2); SBAR(); GAPA(C0=__builtin_amdgcn_mfma_f32_32x32x16_bf16(kf[4],qr[2],C0,0,0,0),   P1[2],P1[3],P1[4],P1[5],     pw2[0]=PKW(P1,0), pw2[1]=PKW(P1,2), pw2); \
    VRD(6); SBAR(); GAPA(C1=__builtin_amdgcn_mfma_f32_32x32x16_bf16(kf[5],qr[2],C1,0,0,0),   P1[6],P1[7],P1[8],P1[9],     pw2[2]=PKW(P1,4), pw2[3]=PKW(P1,6), pw2); \
    VRD(3); SBAR(); GAPA(C0=__builtin_amdgcn_mfma_f32_32x32x16_bf16(kf[6],qr[3],C0,0,0,0),   P1[10],P1[11],P1[12],P1[13], pw3[0]=PKW(P1,8), pw3[1]=PKW(P1,10), pw3); \
    VRD(7); SBAR(); GAPA(C1=__builtin_amdgcn_mfma_f32_32x32x16_bf16(kf[7],qr[3],C1,0,0,0),   P1[14],P1[15],0.f,0.f,       pw3[2]=PKW(P1,12),pw3[3]=PKW(P1,14), pw3); \
    l_reg+=sacc; \
    if(GK){DMA_K((t)+3,sl_cur);} if(GV){DMA_V((t)+1,sl_next);} \
    CMASK(C0,C1,t); \
    { float a=MX3(C0[0],C0[1],C1[0]),b=MX3(C0[2],C0[3],C1[1]); a=MX3(a,C1[2],C1[3]); \
      _Pragma("unroll") for(int r=4;r<16;r+=4){a=MX3(a,C0[r],C0[r+1]);b=MX3(b,C0[r+2],C0[r+3]);a=MX3(a,C1[r],C1[r+1]);b=MX3(b,C1[r+2],C1[r+3]);} \
      float rm=__builtin_fmaxf(a,b); { auto rr=__builtin_amdgcn_permlane32_swap(__float_as_uint(rm),__float_as_uint(rm),false,false); rm=__builtin_fmaxf(__uint_as_float(rr[0]),__uint_as_float(rr[1])); } \
      resc=false; \
      if(__builtin_expect(__any(rm>(float)THRL),0)){ const float dl=__builtin_fmaxf(rm,0.f); mhat+=dl; \
        _Pragma("unroll") for(int r=0;r<16;++r){C0[r]-=dl;C1[r]-=dl;} \
        _Pragma("unroll") for(int r=0;r<16;++r)negm[r]=-mhat; asm volatile("":"+v"(negm)); \
        const float f=__builtin_amdgcn_exp2f(-dl); l_reg*=f; if(hi==0)wsf[r32]=f; resc=true; } } \
    SBAR(); \
    GAPB(o[0]=__builtin_amdgcn_mfma_f32_32x32x16_bf16(PAF(0),VFR(0),o[0],0,0,0), C0,0); \
    GAPB(o[1]=__builtin_amdgcn_mfma_f32_32x32x16_bf16(PAF(0),VFR(4),o[1],0,0,0), C0,4); \
    KRD(GL,0); GAPB(o[0]=__builtin_amdgcn_mfma_f32_32x32x16_bf16(PAF(1),VFR(1),o[0],0,0,0), C0,8); \
    KRD(GL,1); GAPB(o[1]=__builtin_amdgcn_mfma_f32_32x32x16_bf16(PAF(1),VFR(5),o[1],0,0,0), C0,12); \
    KRD(GL,2); GAPB(o[0]=__builtin_amdgcn_mfma_f32_32x32x16_bf16(PAF(2),VFR(2),o[0],0,0,0), C1,0); \
    KRD(GL,3); GAPB(o[1]=__builtin_amdgcn_mfma_f32_32x32x16_bf16(PAF(2),VFR(6),o[1],0,0,0), C1,4); \
    GAPB(o[0]=__builtin_amdgcn_mfma_f32_32x32x16_bf16(PAF(3),VFR(3),o[0],0,0,0), C1,8); \
    GAPB(o[1]=__builtin_amdgcn_mfma_f32_32x32x16_bf16(PAF(3),VFR(7),o[1],0,0,0), C1,12); \
    }while(0)
  int t=1;
  #undef CMASK
  #define CMASK(P0,P1,t) do{}while(0)
  for(;t+5<NT;t+=2){
    STEP(pB0,pB1,pA0,pA1,t,true,true,true);     WAIT_BAR(2); RESC(); ROT();
    STEP(pA0,pA1,pB0,pB1,t+1,true,true,true);   WAIT_BAR(2); RESC(); ROT();
  }
  #undef CMASK
  #define CMASK(P0,P1,t) do{int jb_=(t)-(NT-4); if(jb_>=0)cmask(P0,P1,jb_,qrel,hi);}while(0)
  #define ENDW(tt) do{ if((tt)+3<NT){WAIT_BAR(2);} else if((tt)+2<NT){WAIT_BAR(1);} else {WAIT_BAR(0);} }while(0)
  for(;t+1<NT;t+=2){
    STEP(pB0,pB1,pA0,pA1,t,(t+3<NT),(t+1<NT),(t+1<NT));       ENDW(t);   RESC(); ROT();
    STEP(pA0,pA1,pB0,pB1,t+1,(t+4<NT),(t+2<NT),(t+2<NT));     ENDW(t+1); RESC(); ROT();
  }
  STEP(pB0,pB1,pA0,pA1,NT-1,false,false,false); RESC();
  { float sacc=pB0[0]+pB0[1]; _Pragma("unroll") for(int r=2;r<16;++r)sacc+=pB0[r]; _Pragma("unroll") for(int r=0;r<16;++r)sacc+=pB1[r]; l_reg+=sacc;
    pw0=(u32x4){PKW(pB0,0),PKW(pB0,2),PKW(pB0,4),PKW(pB0,6)};pw1=(u32x4){PKW(pB0,8),PKW(pB0,10),PKW(pB0,12),PKW(pB0,14)};pw2=(u32x4){PKW(pB1,0),PKW(pB1,2),PKW(pB1,4),PKW(pB1,6)};pw3=(u32x4){PKW(pB1,8),PKW(pB1,10),PKW(pB1,12),PKW(pB1,14)};
    SBAR(); pv(o,vb0+sl_cur,PAF(0),PAF(1),PAF(2),PAF(3)); }
  #undef PKW
  #undef PAF
  #undef VFR
  #undef PIN
  #undef MX3
  #undef GAPA
  #undef GAPB
  #undef EX
  #undef VRD
  #undef KRD
  #undef STEP
  #undef ENDW
  {auto rr=__builtin_amdgcn_permlane32_swap(__float_as_uint(l_reg),__float_as_uint(l_reg),false,false);l_reg=__uint_as_float(rr[0])+__uint_as_float(rr[1]);}
  if(hi==0)wsf[32+r32]=l_reg;asm volatile("s_waitcnt lgkmcnt(0)":::"memory");
  float rli[16];
  #pragma unroll
  for(int r=0;r<16;++r)rli[r]=__builtin_amdgcn_rcpf(wsf[32+crow(r,hi)]);
  #pragma unroll
  for(int r=0;r<16;++r){o[0][r]*=rli[r];o[1][r]*=rli[r];}
  float*stA=stash+(size_t)(wid*32)*64+lane; float*stB=stash+(size_t)((8+wid)*32)*64+lane;
  if(p==0){
    #pragma unroll
    for(int k=0;k<32;++k)stA[k*64]=o[k>>4][k&15];
  }else if(p==2){
    #pragma unroll
    for(int k=0;k<32;++k)stB[k*64]=o[k>>4][k&15];
  }else if(p==1){
    #pragma unroll
    for(int k=0;k<32;++k)stA[k*64]=stA[k*64]-lam*o[k>>4][k&15];
  }else{
    f32x16 fa[2];
    #pragma unroll
    for(int k=0;k<32;++k){o[k>>4][k&15]=stB[k*64]-lam*o[k>>4][k&15]; fa[k>>4][k&15]=stA[k*64];}
    #pragma unroll
    for(int r=0;r<16;++r){
      float ss=fa[0][r]*fa[0][r]+fa[1][r]*fa[1][r]+o[0][r]*o[0][r]+o[1][r]*o[1][r];
      ss+=__shfl_xor(ss,1);ss+=__shfl_xor(ss,2);ss+=__shfl_xor(ss,4);ss+=__shfl_xor(ss,8);ss+=__shfl_xor(ss,16);
      const float rs=1.0f/sqrtf(ss*(1.0f/128.0f)+1e-5f);
      fa[0][r]*=rs;fa[1][r]*=rs;o[0][r]*=rs;o[1][r]*=rs;}
    bf16*stg=(bf16*)(shm+LDS_OST)+wid*2048;
    bf16*Gw=GO+(rowbase+q0+wid*QBLK)*DM+h*128;
    #pragma unroll
    for(int hv=0;hv<2;++hv){
      #pragma unroll
      for(int r=0;r<16;++r){const int orow=crow(r,hi);
        #pragma unroll
        for(int d0=0;d0<2;++d0)stg[orow*64+d0*32+r32]=__float2bfloat16(hv==0?fa[d0][r]:o[d0][r]);}
      asm volatile("s_waitcnt lgkmcnt(0)":::"memory");
      #pragma unroll
      for(int i=0;i<4;++i){const int row=i*8+(lane>>3),ch=lane&7; const u32x4 v=*(const u32x4*)(stg+row*64+ch*8);
        bf16*gp=Gw+(long)row*DM+hv*64+ch*8; const u32x4 gt=*(const u32x4*)gp;
        const float4 s0=*(const float4*)(subg+hv*64+ch*8), s1=*(const float4*)(subg+hv*64+ch*8+4);
        const float sg[8]={s0.x,s0.y,s0.z,s0.w,s1.x,s1.y,s1.z,s1.w}; float rr_[8];
        #pragma unroll
        for(int e=0;e<4;++e){ const unsigned vw=v[e], gw=gt[e];
          const float v0=__uint_as_float(vw<<16), v1=__uint_as_float(vw&0xffff0000u), g0=__uint_as_float(gw<<16), g1=__uint_as_float(gw&0xffff0000u);
          rr_[2*e]=v0*sg[2*e]*0.8f*g0/(1.0f+__expf(-g0)); rr_[2*e+1]=v1*sg[2*e+1]*0.8f*g1/(1.0f+__expf(-g1)); }
        u32x4 ov; ov[0]=cvtpk_s(rr_[0],rr_[1]); ov[1]=cvtpk_s(rr_[2],rr_[3]); ov[2]=cvtpk_s(rr_[4],rr_[5]); ov[3]=cvtpk_s(rr_[6],rr_[7]);
        *(u32x4*)gp=ov; }
      asm volatile("s_waitcnt lgkmcnt(0)":::"memory");
    }
  }
  asm volatile("s_waitcnt lgkmcnt(0)\n\ts_barrier":::"memory");
  #undef DMA_K
  #undef DMA_V
  #undef CMASK
  #undef START
  #undef RESC
  #undef ROT
}
constexpr int ATTN_LDS_BYTES=LDS_BYTES;
#undef SBAR
#undef WAIT_BAR
}
#ifndef PG8_SP2
#define PG8_SP2 true
#endif
#ifndef PG8_ALIGN
#define PG8_ALIGN true
#endif
#include <hip/hip_cooperative_groups.h>
namespace cg = cooperative_groups;
#define LAS __attribute__((address_space(3)))
#define GAS __attribute__((address_space(1)))
typedef unsigned short bf16;
typedef unsigned v4u __attribute__((ext_vector_type(4)));
typedef unsigned v2u __attribute__((ext_vector_type(2)));
typedef float f32x4 __attribute__((ext_vector_type(4)));
typedef short bf16x8 __attribute__((ext_vector_type(8)));
#define LDS_WAIT() asm volatile("s_waitcnt lgkmcnt(0)" ::: "memory")
constexpr int NWAVES = 8;
constexpr int BATCH = 8, SEQ = 4096, D = 1024, M = BATCH * SEQ, NPROJ = 8192;
constexpr float LN_EPS = 1e-5f;
constexpr size_t MiB = 1u << 20;
constexpr size_t WS_WIN = 2 * MiB, WS_WAP = 18 * MiB, WS_WRP = 20 * MiB, WS_WOUT = 22 * MiB, WS_ROPE = 24 * MiB;
constexpr size_t WS_S0 = 32 * MiB, SLOT = 64 * MiB;
constexpr size_t WS_STASH = 480 * MiB, WS_END = 512 * MiB;
constexpr int RING_BYTES = 131072, LDS_BYTES = 147456;
static_assert(attn_body::LDS_BYTES <= RING_BYTES && pg8::STAGE_BYTES <= RING_BYTES, "LDS map");

__device__ __forceinline__ unsigned f2bf(float f) { unsigned u = __builtin_bit_cast(unsigned, f); return (u + 0x7fffu + ((u >> 16) & 1u)) >> 16; }
__device__ __forceinline__ unsigned pk2(float lo, float hi) { return f2bf(lo) | (f2bf(hi) << 16); }
__device__ __forceinline__ float bfu(unsigned short h) { return __builtin_bit_cast(float, (unsigned)h << 16); }
__device__ __forceinline__ float wave_sum(float v) {
#pragma unroll
    for (int o = 1; o < 64; o <<= 1) v += __shfl_xor(v, o);
    return v;
}
__device__ __forceinline__ void p0_transpose_item(const float* W, int K, int N, bf16* WT, LAS float* scr, int item, int lane) {
    const int nblk = N / 32, kb = item / nblk, nb = item % nblk, k0 = 64 * kb, n0 = 32 * nb;
#pragma unroll 8
    for (int i = 0; i < 32; ++i) { const int kk = 2 * i + (lane >> 5); scr[kk * 33 + (lane & 31)] = W[(size_t)(k0 + kk) * N + n0 + (lane & 31)]; }
    LDS_WAIT(); asm volatile("" ::: "memory");
    const int c = lane & 7;
#pragma unroll
    for (int j = 0; j < 4; ++j) { const int n = (lane >> 3) + 8 * j; const LAS float* s = scr + (8 * c) * 33 + n;
        v4u o; o.x = pk2(s[0 * 33], s[1 * 33]); o.y = pk2(s[2 * 33], s[3 * 33]); o.z = pk2(s[4 * 33], s[5 * 33]); o.w = pk2(s[6 * 33], s[7 * 33]);
        *(GAS v4u*)(WT + (size_t)(n0 + n) * K + k0 + 8 * c) = o; }
    LDS_WAIT(); asm volatile("" ::: "memory");
}

struct Args { const float* in[20]; float* out; unsigned char* ws; };

__device__ __forceinline__ void p0_prologue(const float* x, const float* w_in, const float* w_ap, const float* w_rp, const float* w_out, bf16* Win_t, bf16* Wap_t, bf16* Wrp_t, bf16* Wout_t, bf16* XB, float* rope,
                                            LAS unsigned char* lds, int vcu, int G, int wave, int lane) {
    LAS float* scr = (LAS float*)(lds + wave * 16384);
    const int gw = vcu * NWAVES + wave, NGW = G * NWAVES;
    constexpr int I_IN = (D / 64) * (NPROJ / 32), I_SQ = (D / 64) * (D / 32);
    constexpr int NITEMS = I_IN + 3 * I_SQ;
    for (int it = gw; it < NITEMS; it += NGW) {
        int r = it;
        if (r < I_IN) { p0_transpose_item(w_in, D, NPROJ, Win_t, scr, r, lane); continue; } r -= I_IN;
        if (r < I_SQ) { p0_transpose_item(w_ap, D, D, Wap_t, scr, r, lane); continue; } r -= I_SQ;
        if (r < I_SQ) { p0_transpose_item(w_rp, D, D, Wrp_t, scr, r, lane); continue; } r -= I_SQ;
        p0_transpose_item(w_out, D, D, Wout_t, scr, r, lane);
    }
    for (int m = gw; m < M; m += NGW) {
        const GAS f32x4* xr = (const GAS f32x4*)(x + (size_t)m * D) + lane;
        GAS v2u* o8 = (GAS v2u*)(XB + (size_t)m * D) + lane;
#pragma unroll
        for (int j = 0; j < 4; ++j) { const f32x4 v = xr[64 * j]; v2u w; w.x = pk2(v.x, v.y); w.y = pk2(v.z, v.w); o8[64 * j] = w; }
    }
    for (int e = gw * 64 + lane; e < SEQ * 8; e += NGW * 64) {
        const int pos = e >> 3, j = e & 7;
        const float inv = j == 0 ? 1.0f : j == 1 ? 0.1939227432012558f : j == 2 ? 0.03760603070259094f : j == 3 ? 0.007292664609849453f : j == 4 ? 0.0014142135623842478f
                        : j == 5 ? 0.00027424818836152554f : j == 6 ? 5.318296098266728e-05f : 1.0313386155758053e-05f;
        const float angf = (float)pos * inv;
        const double a = (double)angf, kk = __builtin_rint(a * 0.15915494309189535), r = a - kk * 6.283185307179586;
        const double x2 = r * r; double ts = r, tc = 1.0, sn = r, cs = 1.0;
#pragma unroll
        for (int n = 1; n <= 14; ++n) { tc *= -x2 * (1.0 / (double)((2 * n - 1) * (2 * n))); cs += tc; ts *= -x2 * (1.0 / (double)((2 * n) * (2 * n + 1))); sn += ts; }
        rope[pos * 16 + j] = (float)cs; rope[pos * 16 + 8 + j] = (float)sn;
    }
}

constexpr int RN_A = 0, RN_XCF = 34816, RN_AL = 51200, RN_UL = 68096, RN_SP = 84992, RN_SH = 87040, RN_CARRY = 89088;
__device__ __forceinline__ void rnn_unit(int b, int n, int q, const bf16* XR, bf16* GH, const float* conv_w, const float* conv_b, const float* w_a, const float* b_a, const float* w_x, const float* b_x,
                                         const float* lru_lambda, LAS unsigned char* lds) {
    int tid = threadIdx.x; asm volatile("" : "+v"(tid)); const int lane = tid & 63, wave = __builtin_amdgcn_readfirstlane(tid >> 6);
    const int d0 = q * 32, chb = n * 128;
    const int c8 = tid & 15, tg = tid >> 4;
    float cw[4][8], cb[8];
#pragma unroll
    for (int e = 0; e < 8; ++e) { cb[e] = conv_b[chb + c8 * 8 + e];
#pragma unroll
        for (int j = 0; j < 4; ++j) cw[j][e] = conv_w[j * 1024 + chb + c8 * 8 + e]; }
    const int fr = lane & 15, quad = lane >> 4;
    bf16x8 bfr[4][4];
#pragma unroll
    for (int nt = 0; nt < 4; ++nt) { const float* Wg = (nt < 2 ? w_a : w_x) + (size_t)n * 16384 + d0 + (nt & 1) * 16 + fr;
#pragma unroll
        for (int ks = 0; ks < 4; ++ks) { bf16x8 f;
#pragma unroll
            for (int j = 0; j < 8; ++j) f[j] = (short)f2bf(Wg[(size_t)(ks * 32 + quad * 8 + j) * 128]);
            bfr[nt][ks] = f; } }
    float ba[2], bx[2], sp[2];
#pragma unroll
    for (int h2 = 0; h2 < 2; ++h2) { const int ch = chb + d0 + h2 * 16 + fr; ba[h2] = b_a[ch]; bx[h2] = b_x[ch]; sp[h2] = log1pf(__expf(-lru_lambda[ch])); }
    const int dl = tid & 31, seg = tid >> 5;
    LAS unsigned char* A_l = lds + RN_A; LAS float* xcf = (LAS float*)(lds + RN_XCF); LAS float* aL = (LAS float*)(lds + RN_AL); LAS float* uL = (LAS float*)(lds + RN_UL);
    LAS float* sP = (LAS float*)(lds + RN_SP); LAS float* sH = (LAS float*)(lds + RN_SH); LAS float* carry = (LAS float*)(lds + RN_CARRY);
    if (tid < 64) carry[tid] = 0.f;
    const size_t rowbase = (size_t)b * SEQ;
    v4u raw[7];
#pragma unroll
    for (int i = 0; i < 7; ++i) { const int tp = tg * 4 - 3 + i; raw[i] = (v4u){0u, 0u, 0u, 0u}; if (tp >= 0) raw[i] = *(const GAS v4u*)(XR + (rowbase + tp) * 1024 + chb + c8 * 8); }
    for (int ck = 0; ck < SEQ / 128; ++ck) {
        const int t0 = ck * 128;
        {
            float xr[7][8];
#pragma unroll
            for (int i = 0; i < 7; ++i) { xr[i][0] = pg8::bf_lo(raw[i].x); xr[i][1] = pg8::bf_hi(raw[i].x); xr[i][2] = pg8::bf_lo(raw[i].y); xr[i][3] = pg8::bf_hi(raw[i].y);
                                          xr[i][4] = pg8::bf_lo(raw[i].z); xr[i][5] = pg8::bf_hi(raw[i].z); xr[i][6] = pg8::bf_lo(raw[i].w); xr[i][7] = pg8::bf_hi(raw[i].w); }
#pragma unroll
            for (int tl = 0; tl < 4; ++tl) { float xc[8];
#pragma unroll
                for (int e = 0; e < 8; ++e) { float v = cb[e];
#pragma unroll
                    for (int j = 0; j < 4; ++j) v += cw[j][e] * xr[tl + j][e];
                    xc[e] = v; }
                const int t = tg * 4 + tl;
                v4u w; w.x = pk2(xc[0], xc[1]); w.y = pk2(xc[2], xc[3]); w.z = pk2(xc[4], xc[5]); w.w = pk2(xc[6], xc[7]);
                *(LAS v4u*)(A_l + t * 272 + c8 * 16) = w;
                if ((c8 >> 2) == q) { LAS f32x4* xp = (LAS f32x4*)(xcf + t * 32 + (c8 & 3) * 8); xp[0] = (f32x4){xc[0], xc[1], xc[2], xc[3]}; xp[1] = (f32x4){xc[4], xc[5], xc[6], xc[7]}; }
            }
        }
        if (ck + 1 < SEQ / 128) {
#pragma unroll
            for (int i = 0; i < 7; ++i) { const int tp = t0 + 128 + tg * 4 - 3 + i; raw[i] = *(const GAS v4u*)(XR + (rowbase + tp) * 1024 + chb + c8 * 8); }
        }
        bf16* gp = GH + (rowbase + t0 + seg * 8) * 1024 + chb + d0 + dl;
        unsigned short gv[8];
#pragma unroll
        for (int i = 0; i < 8; ++i) gv[i] = gp[(size_t)i * 1024];
        __syncthreads();
        f32x4 acc[4];
#pragma unroll
        for (int nt = 0; nt < 4; ++nt) acc[nt] = (f32x4){0.f, 0.f, 0.f, 0.f};
#pragma unroll
        for (int ks = 0; ks < 4; ++ks) { const bf16x8 af = *(const LAS bf16x8*)(A_l + (wave * 16 + fr) * 272 + ks * 64 + quad * 16);
#pragma unroll
            for (int nt = 0; nt < 4; ++nt) acc[nt] = __builtin_amdgcn_mfma_f32_16x16x32_bf16(af, bfr[nt][ks], acc[nt], 0, 0, 0); }
#pragma unroll
        for (int h2 = 0; h2 < 2; ++h2)
#pragma unroll
            for (int j = 0; j < 4; ++j) { const int t = wave * 16 + quad * 4 + j, cl = h2 * 16 + fr;
                const float r = 1.f / (1.f + __expf(-(acc[h2][j] + ba[h2]))), ig = 1.f / (1.f + __expf(-(acc[2 + h2][j] + bx[h2])));
                const float la = -8.f * r * sp[h2], av = __expf(la), y = 2.f * la;
                const float em1 = y * (1.f + y * (0.5f + y * (1.f / 6.f + y * (1.f / 24.f + y * (1.f / 120.f + y * (1.f / 720.f + y * (1.f / 5040.f)))))));
                const float uv = sqrtf(-em1) * ig * xcf[t * 32 + cl];
                aL[t * 33 + cl] = av; uL[t * 33 + cl] = uv; }
        __syncthreads();
        float as_[8], us_[8]; float P = 1.f, H = 0.f;
#pragma unroll
        for (int i = 0; i < 8; ++i) { as_[i] = aL[(seg * 8 + i) * 33 + dl]; us_[i] = uL[(seg * 8 + i) * 33 + dl]; H = as_[i] * H + us_[i]; P *= as_[i]; }
        sP[seg * 32 + dl] = P; sH[seg * 32 + dl] = H;
        __syncthreads();
        float h = carry[(ck & 1) * 32 + dl];
        for (int s = 0; s < seg; ++s) h = sP[s * 32 + dl] * h + sH[s * 32 + dl];
#pragma unroll
        for (int i = 0; i < 8; ++i) { h = as_[i] * h + us_[i]; const float g = bfu(gv[i]); gp[(size_t)i * 1024] = (bf16)f2bf(h * g / (1.f + __expf(-g))); }
        if (seg == 15) carry[((ck + 1) & 1) * 32 + dl] = h;
        __syncthreads();
    }
}

__device__ __forceinline__ void ln_row_inplace(float* row, const float* g, const float* bta, int lane) {
    GAS f32x4* xr = (GAS f32x4*)row + lane;
    f32x4 v[4]; float s = 0.f;
#pragma unroll
    for (int j = 0; j < 4; ++j) { v[j] = xr[64 * j]; s += (v[j].x + v[j].y) + (v[j].z + v[j].w); }
    const float mean = wave_sum(s) * (1.f / D); float s2 = 0.f;
#pragma unroll
    for (int j = 0; j < 4; ++j) { v[j] = v[j] - mean; s2 += (v[j].x * v[j].x + v[j].y * v[j].y) + (v[j].z * v[j].z + v[j].w * v[j].w); }
    const float rstd = 1.f / sqrtf(wave_sum(s2) * (1.f / D) + LN_EPS);
#pragma unroll
    for (int j = 0; j < 4; ++j) { const f32x4 gg = *((const GAS f32x4*)g + lane + 64 * j), bb = *((const GAS f32x4*)bta + lane + 64 * j); xr[64 * j] = v[j] * rstd * gg + bb; }
}

__global__ void __launch_bounds__(NWAVES * 64, 2) fwd_megakernel(Args args) {
    extern __shared__ __attribute__((aligned(16))) unsigned char lds[];
    cg::grid_group grid = cg::this_grid();
    LAS unsigned char* L = (LAS unsigned char*)lds;
    const int tid = threadIdx.x, lane = tid & 63, wave = __builtin_amdgcn_readfirstlane(tid >> 6);
    const int G = gridDim.x; const int bx = blockIdx.x; const int vcu = (G % 8 == 0) ? (bx % 8) * (G / 8) + bx / 8 : bx;
    unsigned char* ws = args.ws;
    const float* x = args.in[0];
    bf16* Win_t = (bf16*)(ws + WS_WIN); bf16* Wap_t = (bf16*)(ws + WS_WAP); bf16* Wrp_t = (bf16*)(ws + WS_WRP); bf16* Wout_t = (bf16*)(ws + WS_WOUT); float* rope = (float*)(ws + WS_ROPE);
    bf16* S0 = (bf16*)(ws + WS_S0);
    bf16* S1 = (bf16*)(ws + WS_S0 + 1 * SLOT);
    bf16* S2 = (bf16*)(ws + WS_S0 + 2 * SLOT);
    bf16* S3 = (bf16*)(ws + WS_S0 + 3 * SLOT);
    bf16* S4 = (bf16*)(ws + WS_S0 + 4 * SLOT);
    bf16* S5 = (bf16*)(ws + WS_S0 + 5 * SLOT);
    bf16* S6 = (bf16*)(ws + WS_S0 + 6 * SLOT);
    bf16* D0 = (bf16*)args.out;
    bf16* D1 = D0 + (size_t)M * D;
    float* stash = (float*)(ws + WS_STASH) + (size_t)bx * 32768;

    p0_prologue(x, args.in[1], args.in[15], args.in[16], args.in[17], Win_t, Wap_t, Wrp_t, Wout_t, D0, rope, L, vcu, G, wave, lane);
    grid.sync();
    {
        pg8::Gemm g{D0, Win_t, M, NPROJ, D, nullptr, nullptr}; pg8::StaticOrder S; S.init(M, NPROJ, G, bx);
        pg8::EpiProj E{S0, S1, S2, S3, S4, S5, S6, D1, rope, attn_body::C2, SEQ - 1};
        pg8::gemm_phase<pg8::EpiProj, pg8::StaticOrder, PG8_ALIGN, PG8_SP2>(L, g, S, E);
    }
    grid.sync();
#ifndef NO_RNN
    for (int u = vcu; u < 256; u += G)
        rnn_unit(u >> 5, (u >> 2) & 7, u & 3, S4, S5, args.in[7], args.in[8], args.in[9], args.in[10], args.in[11], args.in[12], args.in[13], L);
#endif
#ifndef NO_ATT
    {
        const float l1 = wave_sum(args.in[2][lane] * args.in[3][lane]), l2 = wave_sum(args.in[4][lane] * args.in[5][lane]);
        const float lam = __builtin_bit_cast(float, __builtin_amdgcn_readfirstlane(__builtin_bit_cast(int, __expf(l1) - __expf(l2) + 0.2f)));
        for (int u = vcu; u < 1024; u += G) {
            const int w = u & 255, i = u >> 8, bh = w >> 2, s = w & 3;
            const int qb = (i == 0) ? s : (i == 1) ? 7 - s : (i == 2) ? 8 + s : 15 - s;
            for (int p = 0; p < 4; ++p)
                attn_body::attn_unit<8>(bh >> 3, bh & 7, qb, p, lam, (const attn_body::bf16*)S0, (const attn_body::bf16*)S1, (const attn_body::bf16*)S2, (attn_body::bf16*)S3, args.in[6], stash, (char*)lds);
        }
    }
#endif
    grid.sync();
    {
        pg8::Gemm g{S3, Wap_t, M, D, D, S5, Wrp_t}; pg8::DualOrder S; S.init(M, D, G, bx);
        pg8::EpiMerge E{S6, D1, args.in[14], S0};
        pg8::gemm_phase<pg8::EpiMerge, pg8::DualOrder, PG8_ALIGN, PG8_SP2>(L, g, S, E);
    }
    grid.sync();
    {
        pg8::Gemm g{S0, Wout_t, M, D, D, nullptr, nullptr}; pg8::StaticOrder S; S.init(M, D, G, bx);
        pg8::EpiResF32 E{x, args.out, 1.189207115002721f};
        pg8::gemm_phase<pg8::EpiResF32, pg8::StaticOrder, PG8_ALIGN, PG8_SP2>(L, g, S, E);
    }
    grid.sync();
    { int t4 = threadIdx.x; asm volatile("" : "+v"(t4)); const int lane4 = t4 & 63, wave4 = __builtin_amdgcn_readfirstlane(t4 >> 6);
    for (int m = vcu * NWAVES + wave4; m < M; m += G * NWAVES) ln_row_inplace(args.out + (size_t)m * D, args.in[18], args.in[19], lane4); }
}

extern "C" void kernel_launch(void* const* d_in, const int* in_sizes, int n_in, void* d_out, int out_size, void* d_ws, size_t ws_size, hipStream_t stream) {
    static int grid = 0;
    if (grid == 0) {
        if (n_in != 20 || in_sizes[0] != M * D || out_size != M * D || ws_size < WS_END) { fprintf(stderr, "kernel_launch: unexpected shapes (n_in %d, in0 %d, out %d, ws %zu); nothing launched\n", n_in, n_in > 0 ? in_sizes[0] : -1, out_size, ws_size); grid = -1; return; }
        int dev = 0, cus = 0, per_cu = 0;
        if (hipGetDevice(&dev) != hipSuccess || hipDeviceGetAttribute(&cus, hipDeviceAttributeMultiprocessorCount, dev) != hipSuccess) { grid = -1; return; }
        if (hipFuncSetAttribute((const void*)fwd_megakernel, hipFuncAttributeMaxDynamicSharedMemorySize, LDS_BYTES) != hipSuccess) { fprintf(stderr, "kernel_launch: hipFuncSetAttribute failed\n"); grid = -1; return; }
        if (hipOccupancyMaxActiveBlocksPerMultiprocessor(&per_cu, (const void*)fwd_megakernel, NWAVES * 64, LDS_BYTES) != hipSuccess || per_cu < 1) { fprintf(stderr, "kernel_launch: occupancy query says %d\n", per_cu); per_cu = 1; }
        (void)hipGetLastError();
        grid = cus;
    }
    if (grid < 0) return;
    Args a{};
    for (int i = 0; i < 20; ++i) a.in[i] = (const float*)d_in[i];
    a.out = (float*)d_out; a.ws = (unsigned char*)d_ws;
    void* kargs[] = {&a};
    const hipError_t e = hipLaunchCooperativeKernel((const void*)fwd_megakernel, dim3(grid), dim3(NWAVES * 64), kargs, LDS_BYTES, stream);
    if (e != hipSuccess) fprintf(stderr, "kernel_launch: cooperative launch failed: %s (grid %d)\n", hipGetErrorString(e), grid);
}
```

```cpp
#include <hip/hip_runtime.h>
#include <cstdio>
#include <cstdint>
namespace pg8 {
#define PG8_LAS __attribute__((address_space(3)))
typedef unsigned short bf16_t;
typedef short bf16x8 __attribute__((ext_vector_type(8)));
typedef float f32x4 __attribute__((ext_vector_type(4)));
typedef unsigned u32x4 __attribute__((ext_vector_type(4)));
constexpr int BM = 256, BK = 64, HALF = 128, HTB = HALF * BK * 2  , STAGE_BYTES = 8 * HTB, NXCD = 8, WGM = 8;

__host__ __device__ __forceinline__ int lds_byte(int r, int c) { const int st = (r >> 4) * 2 + (c >> 5), rr = r & 15, cc = c & 31, ob = rr * 64 + cc * 2; return st * 1024 + (ob ^ (((ob >> 9) & 1) << 5)); }
__host__ __device__ __forceinline__ void stage_rc(int b, int& R, int& C) { const int st = b / 1024, sb = b % 1024, swz = sb ^ (((sb >> 9) & 1) << 5); R = (st >> 1) * 16 + swz / 64; C = (st & 1) * 32 + (swz % 64) / 2; }
__host__ __device__ __forceinline__ int perm32(int rho) { const int n = rho >> 4, i = rho & 15; return 8 * (i >> 2) + 4 * n + (i & 3); }

struct Unit { int pm, pn, seg; };
struct Gemm { const bf16_t* A; const bf16_t* Bt; int M, N, K; const bf16_t* A2; const bf16_t* Bt2; };

struct StaticOrder {
    int nM, nN, nwg, G, c;
    __host__ __device__ void init(int M, int N, int G_, int c_) { nM = M / BM; nN = N / BM; nwg = nM * nN; G = G_; c = c_; }
    __host__ __device__ bool next(int i, Unit& u) const {
        const long L = (long)i * G + c; if (L >= nwg) return false;
        int wgid = (int)L; { const int q = nwg / NXCD, r = nwg % NXCD, xcd = wgid % NXCD, off = wgid / NXCD; wgid = (xcd < r ? xcd * (q + 1) : r * (q + 1) + (xcd - r) * q) + off; }
        const int nig = WGM * nN, gid = wgid / nig, fm = gid * WGM, gsz = (nM - fm) < WGM ? (nM - fm) : WGM;
        u.pm = fm + ((wgid % nig) % gsz); u.pn = (wgid % nig) / gsz; u.seg = 0; return true;
    }
    __device__ __forceinline__ void a_ready(const Unit&) const {}
    __device__ __forceinline__ void done(const Unit&) const {}
};

__device__ __forceinline__ unsigned cvt_pk_bf16(float lo, float hi) { unsigned r; asm volatile("v_cvt_pk_bf16_f32 %0, %1, %2" : "=v"(r) : "v"(lo), "v"(hi)); return r; }
typedef float f32x2 __attribute__((ext_vector_type(2)));
__device__ __forceinline__ f32x2 gelu_pk(f32x2 v) {
    const f32x2 av = __builtin_elementwise_abs(v), d = av * 0.2316418882f + 1.0f;
    f32x2 t; t.x = __builtin_amdgcn_rcpf(d.x); t.y = __builtin_amdgcn_rcpf(d.y);
    f32x2 q = t * 0.5307027145f + (-0.7265760135f); q = q * t + 0.7107068705f; q = q * t + (-0.142248368f); q = q * t + 0.127414796f; q = q * t;
    const f32x2 s = (v * v) * (-0.72134752044f);
    f32x2 e; e.x = __builtin_amdgcn_exp2f(s.x); e.y = __builtin_amdgcn_exp2f(s.y);
    const f32x2 m = v * (q * e), r = v - m;
    f32x2 o; o.x = v.x < 0.f ? m.x : r.x; o.y = v.y < 0.f ? m.y : r.y; return o;
}

template <int ACT  > struct EpiBf16 {
    static constexpr bool PERM = true, AFTER_DRAIN = false; static_assert(ACT == 0 || ACT == 1, "EpiBf16: ACT is 0 (none) or 1 (gelu_pk)");
    bf16_t* O; int ldc; const float* bias; int split_cols; size_t split_stride; float scale0;
    __device__ __forceinline__ void operator()(const f32x4 (&acc)[2][2][4][2], const Unit& u, int wr, int wc, int fr, int fq) const {
        const int row0 = u.pm * BM + wr * 64 + fr; int colt = u.pn * BM; bf16_t* base = O;
        float sc = 1.f; if (split_cols) { const int t = colt / split_cols; base += (size_t)t * split_stride; colt -= t * split_cols; if (t == 0) sc = scale0; }
        const int col0 = colt + wc * 32 + 8 * fq, bcol0 = u.pn * BM + wc * 32 + 8 * fq;
        f32x4 bv[2][2];
#pragma unroll
        for (int bj = 0; bj < 2; ++bj)
#pragma unroll
            for (int n = 0; n < 2; ++n) bv[bj][n] = bias ? *(const f32x4*)(bias + bcol0 + bj * HALF + 4 * n) : (f32x4){0.f, 0.f, 0.f, 0.f};
#pragma unroll
        for (int ai = 0; ai < 2; ++ai)
#pragma unroll
            for (int m = 0; m < 4; ++m) { bf16_t* rowp = base + (size_t)(row0 + ai * HALF + m * 16) * ldc + col0;
#pragma unroll
                for (int bj = 0; bj < 2; ++bj) { f32x4 v0 = acc[ai][bj][m][0] + bv[bj][0], v1 = acc[ai][bj][m][1] + bv[bj][1];
                    if (ACT == 1) { f32x2 a = gelu_pk((f32x2){v0[0], v0[1]}), b = gelu_pk((f32x2){v0[2], v0[3]}), c = gelu_pk((f32x2){v1[0], v1[1]}), d = gelu_pk((f32x2){v1[2], v1[3]});
                        v0 = (f32x4){a.x, a.y, b.x, b.y}; v1 = (f32x4){c.x, c.y, d.x, d.y}; }
                    v0 = v0 * sc; v1 = v1 * sc; u32x4 w; w.x = cvt_pk_bf16(v0[0], v0[1]); w.y = cvt_pk_bf16(v0[2], v0[3]); w.z = cvt_pk_bf16(v1[0], v1[1]); w.w = cvt_pk_bf16(v1[2], v1[3]);
                    *(u32x4*)(rowp + bj * HALF) = w; } }
    }
};

__device__ __forceinline__ float bf_lo(unsigned w) { return __builtin_bit_cast(float, w << 16); }
__device__ __forceinline__ float bf_hi(unsigned w) { return __builtin_bit_cast(float, w & 0xffff0000u); }
struct EpiProj {
    static constexpr bool PERM = true, AFTER_DRAIN = false;
    bf16_t *d0, *d1, *d2, *d3, *d4, *d5, *d6, *d7; const float* rope; float qscale; int seqmask;
    __device__ __forceinline__ void operator()(f32x4 (&acc)[2][2][4][2], const Unit& u, int wr, int wc, int fr, int fq) const {
        const int grp = u.pn >> 2;
        bf16_t* base = grp == 0 ? d0 : grp == 1 ? d1 : grp == 2 ? d2 : grp == 3 ? d3 : grp == 4 ? d4 : grp == 5 ? d5 : grp == 6 ? d6 : d7;
        const int row0 = u.pm * BM + wr * 64 + fr, col0 = (u.pn & 3) * BM + wc * 32 + 8 * fq;
        const bool rot = (grp < 2) && ((wc & 1) == 0);
        const float sc = (grp == 0) ? qscale : 1.f;
#pragma unroll
        for (int ai = 0; ai < 2; ++ai)
#pragma unroll
            for (int m = 0; m < 4; ++m) {
                const int row = row0 + ai * HALF + m * 16;
                f32x4 cs0 = {1.f, 1.f, 1.f, 1.f}, cs1 = cs0, sn0 = {0.f, 0.f, 0.f, 0.f}, sn1 = sn0;
                if (rot) { const float* rp = rope + (size_t)(row & seqmask) * 16; cs0 = *(const f32x4*)(rp); cs1 = *(const f32x4*)(rp + 4); sn0 = *(const f32x4*)(rp + 8); sn1 = *(const f32x4*)(rp + 12);
                    if (fq == 0) { sn0 = -sn0; sn1 = -sn1; } if (fq >= 2) { sn0 = (f32x4){0.f, 0.f, 0.f, 0.f}; sn1 = sn0; cs0 = (f32x4){1.f, 1.f, 1.f, 1.f}; cs1 = cs0; } }
                bf16_t* rowp = base + (size_t)row * 1024 + col0;
#pragma unroll
                for (int bj = 0; bj < 2; ++bj) {
                    f32x4 v0 = acc[ai][bj][m][0], v1 = acc[ai][bj][m][1];
                    if (rot) { f32x4 p0, p1;
#pragma unroll
                        for (int e = 0; e < 4; ++e) { p0[e] = __shfl_xor(v0[e], 16); p1[e] = __shfl_xor(v1[e], 16); }
                        v0 = v0 * cs0 + p0 * sn0; v1 = v1 * cs1 + p1 * sn1; }
                    v0 = v0 * sc; v1 = v1 * sc;
                    u32x4 w; w.x = cvt_pk_bf16(v0[0], v0[1]); w.y = cvt_pk_bf16(v0[2], v0[3]); w.z = cvt_pk_bf16(v1[0], v1[1]); w.w = cvt_pk_bf16(v1[2], v1[3]);
                    *(u32x4*)(rowp + bj * HALF) = w; }
            }
    }
};
struct EpiMerge {
    static constexpr bool PERM = true, AFTER_DRAIN = false;
    const bf16_t* matt; const bf16_t* mrnn; const float* mb; bf16_t* O;
    __device__ __forceinline__ void operator()(f32x4 (&acc)[2][2][4][2], const Unit& u, int wr, int wc, int fr, int fq) const {
        const int row0 = u.pm * BM + wr * 64 + fr, col0 = u.pn * BM + wc * 32 + 8 * fq;
#pragma unroll
        for (int bj = 0; bj < 2; ++bj) {
            const int col = col0 + bj * HALF;
            const f32x4 br0 = *(const f32x4*)(mb + 1024 + col), br1 = *(const f32x4*)(mb + 1024 + col + 4);
            const f32x4 ba0 = *(const f32x4*)(mb + col), ba1 = *(const f32x4*)(mb + col + 4);
#pragma unroll
            for (int ai = 0; ai < 2; ++ai)
#pragma unroll
                for (int m = 0; m < 4; ++m) {
                    const size_t off = (size_t)(row0 + ai * HALF + m * 16) * 1024 + col;
                    const u32x4 wr_ = *(const u32x4*)(mrnn + off);
                    float er[8];
                    er[0] = __expf(-(bf_lo(wr_.x) + br0[0])); er[1] = __expf(-(bf_hi(wr_.x) + br0[1])); er[2] = __expf(-(bf_lo(wr_.y) + br0[2])); er[3] = __expf(-(bf_hi(wr_.y) + br0[3]));
                    er[4] = __expf(-(bf_lo(wr_.z) + br1[0])); er[5] = __expf(-(bf_hi(wr_.z) + br1[1])); er[6] = __expf(-(bf_lo(wr_.w) + br1[2])); er[7] = __expf(-(bf_hi(wr_.w) + br1[3]));
                    f32x4 v0 = acc[ai][bj][m][0], v1 = acc[ai][bj][m][1];
                    if (u.seg == 0) {
                        const u32x4 wa_ = *(const u32x4*)(matt + off);
                        float ea[8];
                        ea[0] = __expf(-(bf_lo(wa_.x) + ba0[0])); ea[1] = __expf(-(bf_hi(wa_.x) + ba0[1])); ea[2] = __expf(-(bf_lo(wa_.y) + ba0[2])); ea[3] = __expf(-(bf_hi(wa_.y) + ba0[3]));
                        ea[4] = __expf(-(bf_lo(wa_.z) + ba1[0])); ea[5] = __expf(-(bf_hi(wa_.z) + ba1[1])); ea[6] = __expf(-(bf_lo(wa_.w) + ba1[2])); ea[7] = __expf(-(bf_hi(wa_.w) + ba1[3]));
#pragma unroll
                        for (int e = 0; e < 4; ++e) { v0[e] *= (1.f + er[e]) / (1.f + ea[e]); v1[e] *= (1.f + er[4 + e]) / (1.f + ea[4 + e]); }
                        acc[ai][bj][m][0] = v0; acc[ai][bj][m][1] = v1;
                    } else {
#pragma unroll
                        for (int e = 0; e < 4; ++e) { v0[e] = v0[e] / (1.f + er[e]); v1[e] = v1[e] / (1.f + er[4 + e]); }
                        u32x4 w; w.x = cvt_pk_bf16(v0[0], v0[1]); w.y = cvt_pk_bf16(v0[2], v0[3]); w.z = cvt_pk_bf16(v1[0], v1[1]); w.w = cvt_pk_bf16(v1[2], v1[3]);
                        *(u32x4*)(O + off) = w;
                    }
                }
        }
    }
};
struct EpiResF32 {
    static constexpr bool PERM = false, AFTER_DRAIN = false;
    const float* x; float* out; float alpha;
    __device__ __forceinline__ void operator()(f32x4 (&acc)[2][2][4][2], const Unit& u, int wr, int wc, int fr, int fq) const {
        const int col0 = u.pn * BM + wc * 32 + 4 * fq;
#pragma unroll
        for (int ai = 0; ai < 2; ++ai)
#pragma unroll
            for (int m = 0; m < 4; ++m) { const size_t off = (size_t)(u.pm * BM + ai * HALF + wr * 64 + m * 16 + fr) * 1024 + col0;
#pragma unroll
                for (int bj = 0; bj < 2; ++bj)
#pragma unroll
                    for (int n = 0; n < 2; ++n) { const f32x4 xv = *(const f32x4*)(x + off + bj * HALF + n * 16); *(f32x4*)(out + off + bj * HALF + n * 16) = xv * alpha + acc[ai][bj][m][n]; } }
    }
};
struct DualOrder {
    StaticOrder so;
    __host__ __device__ void init(int M, int N, int G_, int c_) { so.init(M, N, G_, c_); }
    __host__ __device__ bool next(int i, Unit& u) const { if (!so.next(i >> 1, u)) return false; u.seg = i & 1; return true; }
    __device__ __forceinline__ void a_ready(const Unit&) const {}
    __device__ __forceinline__ void done(const Unit&) const {}
};


template <class Epi, class Sched, bool ALIGN_EPI = false, bool SP2 = false>
__device__ __forceinline__ void gemm_phase(PG8_LAS unsigned char* lds, const Gemm g, const Sched& S, const Epi& E) {
    int tid = threadIdx.x; asm volatile("" : "+v"(tid));
    const int wid = __builtin_amdgcn_readfirstlane(tid >> 6), lane = tid & 63, wr = wid >> 2, wc = wid & 3, fr = lane & 15, fq = lane >> 4;
    const int K = g.K, nt = K / BK;
    unsigned voffA[2], voffB[2];
#pragma unroll
    for (int i = 0; i < 2; ++i) { int R, C; stage_rc(tid * 16 + i * 8192, R, C); const int Rb = Epi::PERM ? ((R & ~31) + perm32(R & 31)) : R;
        voffA[i] = (unsigned)(R * K + C) * 2u; voffB[i] = (unsigned)(Rb * K + C) * 2u; }
    const size_t kstep = (size_t)(BK * 2);
    const size_t hstep = (size_t)HALF * K * 2;
    const size_t tstep = 2 * hstep;
    const unsigned ldsw = (unsigned)wid * 1024u;
    const int aoff = lds_byte(wr * 64 + fr, fq * 8), boff = lds_byte(wc * 32 + fr, fq * 8);
#define PG8_SA(b, h) (((b) * 2 + (h)) * HTB)
#define PG8_SB(b, h) ((4 + (b) * 2 + (h)) * HTB)
#define PG8_STAGE(bufoff, gbase, voff) do { _Pragma("unroll") for (int _i = 0; _i < 2; ++_i) \
        __builtin_amdgcn_global_load_lds((const unsigned*)((const char*)(gbase) + (voff)[_i]), (PG8_LAS unsigned*)(lds + (bufoff) + ldsw + _i * 8192), 16, 0, 0); } while (0)
#define PG8_LDA(dst, b, h) do { _Pragma("unroll") for (int m = 0; m < 4; ++m) _Pragma("unroll") for (int k = 0; k < 2; ++k) dst[m][k] = *(const PG8_LAS bf16x8*)(lds + PG8_SA(b, h) + aoff + m * 2048 + k * 1024); } while (0)
#define PG8_LDB(dst, b, h) do { _Pragma("unroll") for (int n = 0; n < 2; ++n) _Pragma("unroll") for (int k = 0; k < 2; ++k) dst[n][k] = *(const PG8_LAS bf16x8*)(lds + PG8_SB(b, h) + boff + n * 2048 + k * 1024); } while (0)
#define PG8_MMA(ai, bj, At, Bt) do { __builtin_amdgcn_s_setprio(1); _Pragma("unroll") for (int m = 0; m < 4; ++m) _Pragma("unroll") for (int n = 0; n < 2; ++n) _Pragma("unroll") for (int k = 0; k < 2; ++k) \
        acc[ai][bj][m][n] = __builtin_amdgcn_mfma_f32_16x16x32_bf16(Bt[n][k], At[m][k], acc[ai][bj][m][n], 0, 0, 0); __builtin_amdgcn_s_setprio(0); } while (0)
#define PG8_WAIT_V(n) asm volatile("s_waitcnt vmcnt(" #n ")" ::: "memory")
#define PG8_WAIT_L(n) asm volatile("s_waitcnt lgkmcnt(" #n ")" ::: "memory")
#define PG8_BAR __builtin_amdgcn_s_barrier()
#define PG8_SCHED __builtin_amdgcn_sched_barrier(0)
    Unit cur, nxt; int ui = 0;
    if (!S.next(0, cur)) return;
    f32x4 acc[2][2][4][2];
#pragma unroll
    for (int a = 0; a < 2; ++a)
#pragma unroll
        for (int b = 0; b < 2; ++b)
#pragma unroll
            for (int m = 0; m < 4; ++m)
#pragma unroll
                for (int n = 0; n < 2; ++n) acc[a][b][m][n] = (f32x4){0.f, 0.f, 0.f, 0.f};
    bf16x8 At[4][2], B0[2][2], B1[2][2];
    const char* cA = (const char*)(cur.seg ? g.A2 : g.A) + (size_t)cur.pm * tstep; const char* cB = (const char*)(cur.seg ? g.Bt2 : g.Bt) + (size_t)cur.pn * tstep;
    S.a_ready(cur);
    if constexpr (SP2) {
        PG8_STAGE(PG8_SB(0, 0), cB, voffB); PG8_STAGE(PG8_SB(0, 1), cB + hstep, voffB); PG8_STAGE(PG8_SA(0, 0), cA, voffA); PG8_STAGE(PG8_SA(0, 1), cA + hstep, voffA);
        if (wr == 1) PG8_BAR;
        PG8_WAIT_V(2); PG8_BAR;
        PG8_STAGE(PG8_SB(1, 0), cB + kstep, voffB); PG8_STAGE(PG8_SA(1, 0), cA + kstep, voffA); PG8_STAGE(PG8_SB(1, 1), cB + hstep + kstep, voffB);
        PG8_WAIT_V(6); PG8_BAR;
    } else {
        PG8_STAGE(PG8_SB(0, 0), cB, voffB); PG8_STAGE(PG8_SA(0, 0), cA, voffA); PG8_STAGE(PG8_SB(0, 1), cB + hstep, voffB); PG8_STAGE(PG8_SA(0, 1), cA + hstep, voffA);
        if (wr == 1) PG8_BAR;
        PG8_WAIT_V(4); PG8_BAR;
        PG8_STAGE(PG8_SB(1, 0), cB + kstep, voffB); PG8_STAGE(PG8_SA(1, 0), cA + kstep, voffA); PG8_STAGE(PG8_SB(1, 1), cB + hstep + kstep, voffB);
        PG8_WAIT_V(6); PG8_BAR;
    }
    for (;;) {
        const bool has_next = S.next(ui + 1, nxt);
        const char* nA = has_next ? (const char*)(nxt.seg ? g.A2 : g.A) + (size_t)nxt.pm * tstep : cA; const char* nB = has_next ? (const char*)(nxt.seg ? g.Bt2 : g.Bt) + (size_t)nxt.pn * tstep : cB;
        for (int t = 0; t < nt; t += 2) {
            const bool last = (t == nt - 2);
            const char* a1 = cA + (size_t)(t + 1) * kstep;
            const char* a2 = last ? nA : cA + (size_t)(t + 2) * kstep; const char* b2 = last ? nB : cB + (size_t)(t + 2) * kstep;
            const char* a3 = a2 + kstep; const char* b3 = b2 + kstep;
            if (last && has_next) S.a_ready(nxt);
            if constexpr (SP2) {
            PG8_LDB(B0, 0, 0); PG8_LDB(B1, 0, 1); PG8_SCHED; PG8_LDA(At, 0, 0); PG8_STAGE(PG8_SA(1, 1), a1 + hstep, voffA);
            PG8_WAIT_V(8); PG8_WAIT_L(0); PG8_BAR; PG8_MMA(0, 0, At, B0); PG8_MMA(0, 1, At, B1); PG8_BAR; PG8_SCHED;
            PG8_LDA(At, 0, 1); PG8_STAGE(PG8_SB(0, 0), b2, voffB); PG8_STAGE(PG8_SB(0, 1), b2 + hstep, voffB); PG8_STAGE(PG8_SA(0, 0), a2, voffA);
            PG8_WAIT_V(8); PG8_WAIT_L(0); PG8_BAR; PG8_MMA(1, 0, At, B0); PG8_MMA(1, 1, At, B1); PG8_BAR; PG8_SCHED;
            PG8_LDB(B0, 1, 0); PG8_LDB(B1, 1, 1); PG8_SCHED; PG8_LDA(At, 1, 0); PG8_STAGE(PG8_SA(0, 1), a2 + hstep, voffA);
            PG8_WAIT_V(8); PG8_WAIT_L(0); PG8_BAR; PG8_MMA(0, 0, At, B0); PG8_MMA(0, 1, At, B1); PG8_BAR; PG8_SCHED;
            PG8_LDA(At, 1, 1); PG8_STAGE(PG8_SB(1, 0), b3, voffB); PG8_STAGE(PG8_SB(1, 1), b3 + hstep, voffB); PG8_STAGE(PG8_SA(1, 0), a3, voffA);
            PG8_WAIT_V(8); PG8_WAIT_L(0); PG8_BAR; PG8_MMA(1, 0, At, B0); PG8_MMA(1, 1, At, B1); PG8_BAR; PG8_SCHED;
            } else {
            PG8_LDB(B0, 0, 0); PG8_SCHED; PG8_LDA(At, 0, 0); PG8_STAGE(PG8_SA(1, 1), a1 + hstep, voffA);
            PG8_WAIT_L(8); PG8_BAR; PG8_WAIT_L(0); PG8_MMA(0, 0, At, B0); PG8_BAR; PG8_SCHED;
            PG8_LDB(B1, 0, 1); PG8_STAGE(PG8_SB(0, 0), b2, voffB);
            PG8_BAR; PG8_WAIT_L(0); PG8_MMA(0, 1, At, B1); PG8_BAR;
            PG8_LDA(At, 0, 1); PG8_STAGE(PG8_SA(0, 0), a2, voffA);
            PG8_BAR; PG8_WAIT_L(0); PG8_MMA(1, 0, At, B0); PG8_BAR; PG8_SCHED;
            PG8_STAGE(PG8_SB(0, 1), b2 + hstep, voffB);
            PG8_WAIT_V(6); PG8_BAR; PG8_MMA(1, 1, At, B1); PG8_BAR;
            PG8_LDB(B0, 1, 0); PG8_SCHED; PG8_LDA(At, 1, 0); PG8_STAGE(PG8_SA(0, 1), a2 + hstep, voffA);
            PG8_WAIT_L(8); PG8_BAR; PG8_WAIT_L(0); PG8_MMA(0, 0, At, B0); PG8_BAR; PG8_SCHED;
            PG8_LDB(B1, 1, 1); PG8_STAGE(PG8_SB(1, 0), b3, voffB);
            PG8_BAR; PG8_WAIT_L(0); PG8_MMA(0, 1, At, B1); PG8_BAR;
            PG8_LDA(At, 1, 1); PG8_STAGE(PG8_SA(1, 0), a3, voffA);
            PG8_BAR; PG8_WAIT_L(0); PG8_MMA(1, 0, At, B0); PG8_BAR; PG8_SCHED;
            PG8_STAGE(PG8_SB(1, 1), b3 + hstep, voffB);
            PG8_WAIT_V(6); PG8_BAR; PG8_MMA(1, 1, At, B1); PG8_BAR;
            }
        }
        if constexpr (ALIGN_EPI) { if (wr == 0) PG8_BAR; }
        if constexpr (!Epi::AFTER_DRAIN) { E(acc, cur, wr, wc, fr, fq); S.done(cur); }
        if (!has_next) break;
        if (nxt.seg == 0) {
#pragma unroll
        for (int a = 0; a < 2; ++a)
#pragma unroll
            for (int b = 0; b < 2; ++b)
#pragma unroll
                for (int m = 0; m < 4; ++m)
#pragma unroll
                    for (int n = 0; n < 2; ++n) acc[a][b][m][n] = (f32x4){0.f, 0.f, 0.f, 0.f};
        }
        cur = nxt; cA = nA; cB = nB; ++ui;
        if constexpr (ALIGN_EPI) { if (wr == 1) PG8_BAR; }
    }
    PG8_WAIT_V(0);
    if constexpr (!ALIGN_EPI) { if (wr == 0) PG8_BAR; }
    PG8_BAR;
    if constexpr (Epi::AFTER_DRAIN) { E.fused(acc, cur, wr, wc, fr, fq, lds, wid, lane); S.done(cur); }
#undef PG8_SA
#undef PG8_SB
#undef PG8_STAGE
#undef PG8_LDA
#undef PG8_LDB
#undef PG8_MMA
#undef PG8_WAIT_V
#undef PG8_WAIT_L
#undef PG8_BAR
#undef PG8_SCHED
}
}

#ifndef PG8_SP2
#define PG8_SP2 true
#endif
#ifndef PG8_ALIGN
#define PG8_ALIGN true
#endif
#include <hip/hip_bf16.h>
#include <cmath>
namespace attn_body {
using bf16=__hip_bfloat16;
using bf16x8=__attribute__((ext_vector_type(8)))short;
using s16x4=__attribute__((ext_vector_type(4)))short;
using f32x16=__attribute__((ext_vector_type(16)))float;
using u32x4=__attribute__((ext_vector_type(4)))unsigned;
constexpr int BATCH=8,NHEAD=8,SEQ=4096,D=64,DM=1024;
constexpr int NW=8,QBLK=32,QB=QBLK*NW,KVBLK=64,NQB=SEQ/QB;
constexpr int ATTN_PITCH=DM, ATTN_UNIT_ROWS=QB;
__device__ __forceinline__ int crow(int r,int hi){return (r&3)+8*(r>>2)+4*hi;}
#define SBAR() __builtin_amdgcn_sched_barrier(0)
__device__ __forceinline__ void cmask(f32x16&p0,f32x16&p1,int jb,int qrel,int hi){
  const float NEG=-INFINITY; int kb=64*jb+4*hi;
  #pragma unroll
  for(int r=0;r<16;++r){int kv=kb+(r&3)+8*(r>>2); if(kv>qrel)p0[r]=NEG; if(kv+32>qrel)p1[r]=NEG;}
}

constexpr int NSLOT=3, SLOTB=8192;
constexpr int LDS_K=0, LDS_V=NSLOT*SLOTB, LDS_WS=2*NSLOT*SLOTB, LDS_OST=LDS_WS+NW*64*4, LDS_BYTES=LDS_OST+NW*4096;
constexpr float C2=0.125f*1.4426950408889634f;
__device__ __forceinline__ void glds16(const void*gsrc,unsigned lds_dst){unsigned keep;
  asm volatile("s_mov_b32 %0, m0\n\ts_mov_b32 m0, %2\n\ts_nop 0\n\tglobal_load_lds_dwordx4 %1, off\n\ts_mov_b32 m0, %0":"=&s"(keep):"v"(gsrc),"s"(lds_dst):"memory");}
__device__ __forceinline__ float max3f(float a,float b,float c){float r;asm("v_max3_f32 %0, %1, %2, %3":"=v"(r):"v"(a),"v"(b),"v"(c));return r;}
__device__ __forceinline__ float max2f(float a,float b){float r;asm("v_max_f32_e32 %0, %1, %2":"=v"(r):"v"(a),"v"(b));return r;}
__device__ __forceinline__ float fadd_s(float a,float b){float r;asm("v_add_f32_e32 %0, %1, %2":"=v"(r):"v"(a),"v"(b));return r;}
__device__ __forceinline__ float fsub_s(float a,float b){float r;asm("v_sub_f32_e32 %0, %1, %2":"=v"(r):"v"(a),"v"(b));return r;}
typedef float f32x2_t __attribute__((ext_vector_type(2))); typedef __bf16 bf16x2_t __attribute__((ext_vector_type(2)));
__device__ __forceinline__ unsigned cvtpk_s(float lo,float hi){f32x2_t v={lo,hi};bf16x2_t b=__builtin_convertvector(v,bf16x2_t);return __builtin_bit_cast(unsigned,b);}
#define WAIT_BAR(N) asm volatile("s_waitcnt vmcnt(" #N ") lgkmcnt(0)\n\ts_barrier":::"memory")

__device__ __forceinline__ void qkt(f32x16&p0,f32x16&p1,const char*Kslot,const bf16x8*qr,const f32x16&negm,int r32,int hi){
  const char*kb=Kslot+hi*1024+r32*16;
  #pragma unroll
  for(int d0=0;d0<4;++d0){
    const bf16x8 b0=*reinterpret_cast<const bf16x8*>(kb+d0*2048);
    const bf16x8 b1=*reinterpret_cast<const bf16x8*>(kb+d0*2048+512);
    if(d0==0){p0=__builtin_amdgcn_mfma_f32_32x32x16_bf16(b0,qr[0],negm,0,0,0);p1=__builtin_amdgcn_mfma_f32_32x32x16_bf16(b1,qr[0],negm,0,0,0);}
    else{p0=__builtin_amdgcn_mfma_f32_32x32x16_bf16(b0,qr[d0],p0,0,0,0);p1=__builtin_amdgcn_mfma_f32_32x32x16_bf16(b1,qr[d0],p1,0,0,0);}}
}
typedef __attribute__((address_space(3))) const char* lds_cptr;
typedef short v4i16_t __attribute__((ext_vector_type(4)));
__device__ __forceinline__ void kload8(bf16x8*kf,lds_cptr kp){
  kf[0]=*(const __attribute__((address_space(3))) bf16x8*)(kp);      kf[1]=*(const __attribute__((address_space(3))) bf16x8*)(kp+512);
  kf[2]=*(const __attribute__((address_space(3))) bf16x8*)(kp+2048); kf[3]=*(const __attribute__((address_space(3))) bf16x8*)(kp+2560);
  kf[4]=*(const __attribute__((address_space(3))) bf16x8*)(kp+4096); kf[5]=*(const __attribute__((address_space(3))) bf16x8*)(kp+4608);
  kf[6]=*(const __attribute__((address_space(3))) bf16x8*)(kp+6144); kf[7]=*(const __attribute__((address_space(3))) bf16x8*)(kp+6656);
}
__device__ __forceinline__ void kload2(bf16x8*kf,lds_cptr kp,int j){ kf[2*j]=*(const __attribute__((address_space(3))) bf16x8*)(kp+j*2048); kf[2*j+1]=*(const __attribute__((address_space(3))) bf16x8*)(kp+j*2048+512); }
__device__ __forceinline__ s16x4 vtr(lds_cptr p){ return __builtin_bit_cast(s16x4,__builtin_amdgcn_ds_read_tr16_b64_v4i16((__attribute__((address_space(3))) v4i16_t*)p)); }
__device__ __forceinline__ float rowmax(const f32x16&p0,const f32x16&p1){
  float a=max3f(p0[0],p0[1],p1[0]),b=max3f(p0[2],p0[3],p1[1]);a=max3f(a,p1[2],p1[3]);
  #pragma unroll
  for(int r=4;r<16;r+=4){a=max3f(a,p0[r],p0[r+1]);b=max3f(b,p0[r+2],p0[r+3]);a=max3f(a,p1[r],p1[r+1]);b=max3f(b,p1[r+2],p1[r+3]);}
  const float m=max2f(a,b);
  auto rr=__builtin_amdgcn_permlane32_swap(__float_as_uint(m),__float_as_uint(m),false,false);
  return max2f(__uint_as_float(rr[0]),__uint_as_float(rr[1]));
}
__device__ __forceinline__ void pv(f32x16*o,int vb,bf16x8 pa0,bf16x8 pa1,bf16x8 pa2,bf16x8 pa3){
  #pragma unroll
  for(int d0=0;d0<2;++d0){s16x4 lo[4],hi[4];
    #pragma unroll
    for(int ks=0;ks<4;++ks){
      asm volatile("ds_read_b64_tr_b16 %0,%1 offset:%c2":"=&v"(lo[ks]):"v"(vb),"i"(d0*4096+ks*1024):"memory");
      asm volatile("ds_read_b64_tr_b16 %0,%1 offset:%c2":"=&v"(hi[ks]):"v"(vb),"i"(d0*4096+ks*1024+512):"memory");}
    asm volatile("s_waitcnt lgkmcnt(0)":::"memory");SBAR();
    #define PK(k) (bf16x8){lo[k][0],lo[k][1],lo[k][2],lo[k][3],hi[k][0],hi[k][1],hi[k][2],hi[k][3]}
    o[d0]=__builtin_amdgcn_mfma_f32_32x32x16_bf16(pa0,PK(0),o[d0],0,0,0);
    o[d0]=__builtin_amdgcn_mfma_f32_32x32x16_bf16(pa1,PK(1),o[d0],0,0,0);
    o[d0]=__builtin_amdgcn_mfma_f32_32x32x16_bf16(pa2,PK(2),o[d0],0,0,0);
    o[d0]=__builtin_amdgcn_mfma_f32_32x32x16_bf16(pa3,PK(3),o[d0],0,0,0);
    #undef PK
  }
}

#ifndef ATTN_STORE16
#define ATTN_STORE16(p,v) (*(u32x4*)(p)=(v))
#endif
template<int THRL> __device__ __forceinline__ void attn_unit(int b,int h,int qb,int p,float lam,const bf16*Q,const bf16*__restrict__ K,const bf16*__restrict__ V,bf16*GO,const float*__restrict__ subg,float*stash,char*shm){
  int tid=threadIdx.x; asm volatile("":"+v"(tid)); const int lane=tid&63,r32=lane&31,hi=lane>>5; const int wid=__builtin_amdgcn_readfirstlane(tid>>6);
  const long rowbase=(long)b*SEQ; const int q0=qb*QB;
  const int qkcol=h*128+(p&1)*64, vcol=h*128+(p>>1)*64;
  const bf16*Qw=Q+(rowbase+q0+wid*QBLK)*DM+qkcol;
  const bf16*Kh=K+rowbase*DM+qkcol,*Vh=V+rowbase*DM+vcol;
  const unsigned lds0=(unsigned)(uintptr_t)shm;
  float*wsf=(float*)(shm+LDS_WS)+wid*64;
  const bf16*ksrc=Kh+(long)lane*DM+wid*8;
  const bf16*vsrc=Vh+(long)(16*(wid&3)+(lane>>2))*DM+(wid>>2)*32+(lane&3)*8;
  const unsigned kdst=lds0+LDS_K+wid*1024, vdst=lds0+LDS_V+wid*1024;
  #define DMA_K(t,slot) glds16(ksrc+(long)(t)*KVBLK*DM,(unsigned)__builtin_amdgcn_readfirstlane(kdst+(slot)))
  #define DMA_V(t,slot) glds16(vsrc+(long)(t)*KVBLK*DM,(unsigned)__builtin_amdgcn_readfirstlane(vdst+(slot)))
  const int vb0=(int)(lds0+LDS_V)+((lane>>4)&1)*32+(lane&3)*8+(4*hi+((lane&15)>>2))*64;
  const char*Kbase=shm+LDS_K; bf16x8 kf[8];
  const lds_cptr shm3=(lds_cptr)shm; const lds_cptr kp0=shm3+LDS_K+hi*1024+r32*16; const lds_cptr vp0=shm3+LDS_V+((lane>>4)&1)*32+(lane&3)*8+(4*hi+((lane&15)>>2))*64;
  const int NT=(q0+QB)/KVBLK;
  DMA_K(0,0);DMA_V(0,0);DMA_K(1,SLOTB);
  bf16x8 qr[4];
  #pragma unroll
  for(int d0=0;d0<4;++d0)qr[d0]=*reinterpret_cast<const bf16x8*>(&Qw[(long)r32*DM+d0*16+hi*8]);
  float mhat=0.f,l_reg=0.f;f32x16 o[2];o[0]=f32x16{};o[1]=f32x16{};f32x16 negm=f32x16{};asm volatile("":"+v"(negm));
  const int qrel=wid*QBLK+r32;
  #define CMASK(P0,P1,t) do{int jb_=(t)-(NT-4); if(jb_>=0)cmask(P0,P1,jb_,qrel,hi);}while(0)
  bool resc=false;
  #define START(P0,P1) do{ const float rm=rowmax(P0,P1); resc=false; \
    { const float dl=rm; mhat=fadd_s(mhat,dl); \
      _Pragma("unroll") for(int r=0;r<16;++r){P0[r]=fsub_s(P0[r],dl);P1[r]=fsub_s(P1[r],dl);} \
      _Pragma("unroll") for(int r=0;r<16;++r)negm[r]=-mhat; asm volatile("":"+v"(negm)); } \
    _Pragma("unroll") for(int r=0;r<16;++r)P0[r]=__builtin_amdgcn_exp2f(P0[r]); }while(0)
  #define RESC() do{ if(resc){ asm volatile("s_waitcnt lgkmcnt(0)":::"memory"); \
      _Pragma("unroll") for(int d_=0;d_<2;++d_) _Pragma("unroll") for(int r=0;r<16;++r)o[d_][r]*=wsf[crow(r,hi)]; } }while(0)
  f32x16 pA0,pA1,pB0,pB1;
  int sl_prev=0,sl_cur=0,sl_next=SLOTB;
  #define ROT() do{sl_prev=sl_cur;sl_cur=sl_next;sl_next=(sl_next==(NSLOT-1)*SLOTB)?0:sl_next+SLOTB;}while(0)
  DMA_K(2,2*SLOTB);
  WAIT_BAR(3);
  qkt(pA0,pA1,Kbase,qr,negm,r32,hi);asm volatile("s_nop 15\n\ts_nop 7":"+v"(pA0),"+v"(pA1));CMASK(pA0,pA1,0);
  START(pA0,pA1);
  _Pragma("unroll") for(int r=0;r<16;++r)pA1[r]=__builtin_amdgcn_exp2f(pA1[r]);
  WAIT_BAR(0);
  DMA_K(3,0);DMA_V(1,SLOTB);
  ROT();
  kload8(kf,kp0+sl_cur);
  WAIT_BAR(2);
  s16x4 vlo[8],vhi[8]; u32x4 pw0,pw1,pw2,pw3;
  #define PKW(P,B) cvtpk_s(P[B],P[B+1])
  #define PAF(k) __builtin_bit_cast(bf16x8,pw##k)
  #define VFR(i) (bf16x8){vlo[i][0],vlo[i][1],vlo[i][2],vlo[i][3],vhi[i][0],vhi[i][1],vhi[i][2],vhi[i][3]}
  #define PIN(x) asm volatile("":"+v"(x))
  #define MX3(a,b,c) __builtin_fmaxf(__builtin_fmaxf((a),(b)),(c))
  #define GAPA(MF,A0,A1,A2,A3,W0,W1,PW) do{ MF; sacc+=A0; sacc+=A1; sacc+=A2; sacc+=A3; PIN(sacc); W0; W1; PIN(PW); SBAR(); }while(0)
  #define EX(v) __builtin_amdgcn_exp2f(v)
  #define GAPB(MF,X,B) do{ MF; X[B]=EX(X[B]); X[B+1]=EX(X[B+1]); X[B+2]=EX(X[B+2]); X[B+3]=EX(X[B+3]); PIN(X); SBAR(); }while(0)
  #define VRD(i) do{ vlo[i]=vtr(vp_+(((i)>>2)*4096+((i)&3)*1024)); vhi[i]=vtr(vp_+(((i)>>2)*4096+((i)&3)*1024+512)); }while(0)
  #define KRD(G,j) do{ if(G){ kload2(kf,kp0+sl_next,j); SBAR(); } }while(0)
  #define STEP(C0,C1,P0,P1,t,GK,GV,GL) do{ SBAR(); \
    const lds_cptr vp_=vp0+sl_prev; \
    VRD(0); SBAR(); float sacc=(P0[0]+P0[1]); \
    GAPA(C0=__builtin_amdgcn_mfma_f32_32x32x16_bf16(kf[0],qr[0],negm,0,0,0), P0[2],P0[3],P0[4],P0[5],     pw0[0]=PKW(P0,0), pw0[1]=PKW(P0,2), pw0); \
    VRD(4); SBAR(); GAPA(C1=__builtin_amdgcn_mfma_f32_32x32x16_bf16(kf[1],qr[0],negm,0,0,0), P0[6],P0[7],P0[8],P0[9],     pw0[2]=PKW(P0,4), pw0[3]=PKW(P0,6), pw0); \
    VRD(1); SBAR(); GAPA(C0=__builtin_amdgcn_mfma_f32_32x32x16_bf16(kf[2],qr[1],C0,0,0,0),   P0[10],P0[11],P0[12],P0[13], pw1[0]=PKW(P0,8), pw1[1]=PKW(P0,10), pw1); \
    VRD(5); SBAR(); GAPA(C1=__builtin_amdgcn_mfma_f32_32x32x16_bf16(kf[3],qr[1],C1,0,0,0),   P0[14],P0[15],P1[0],P1[1],   pw1[2]=PKW(P0,12),pw1[3]=PKW(P0,14), pw1); \
    VRD(2); SBAR(); GAPA(C0=__builtin_amdgcn_mfma_f32_32x32x16_bf16(kf[4],qr[2],C0,0,0,0),   P1[2],P1[3],P1[4],P1[5],     pw2[0]=PKW(P1,0), pw2[1]=PKW(P1,2), pw2); \
    VRD(6); SBAR(); GAPA(C1=__builtin_amdgcn_mfma_f32_32x32x16_bf16(kf[5],qr[2],C1,0,0,0),   P1[6],P1[7],P1[8],P1[9],     pw2[2]=PKW(P1,4), pw2[3]=PKW(P1,6), pw2); \
    VRD(3); SBAR(); GAPA(C0=__builtin_amdgcn_mfma_f32_32x32x16_bf16(kf[6],qr[3],C0,0,0,0),   P1[10],P1[11],P1[12],P1[13], pw3[0]=PKW(P1,8), pw3[1]=PKW(P1,10), pw3); \
    VRD(7); SBAR(); GAPA(C1=__builtin_amdgcn_mfma_f32_32x32x16_bf16(kf[7],qr[3],C1,0,0,0),   P1[14],P1[15],0.f,0.f,       pw3[2]=PKW(P1,12),pw3[3]=PKW(P1,14), pw3); \
    l_reg+=sacc; \
    if(GK){DMA_K((t)+3,sl_cur);} if(GV){DMA_V((t)+1,sl_next);} \
    CMASK(C0,C1,t); \
    { float a=MX3(C0[0],C0[1],C1[0]),b=MX3(C0[2],C0[3],C1[1]); a=MX3(a,C1[2],C1[3]); \
      _Pragma("unroll") for(int r=4;r<16;r+=4){a=MX3(a,C0[r],C0[r+1]);b=MX3(b,C0[r+2],C0[r+3]);a=MX3(a,C1[r],C1[r+1]);b=MX3(b,C1[r+2],C1[r+3]);} \
      float rm=__builtin_fmaxf(a,b); { auto rr=__builtin_amdgcn_permlane32_swap(__float_as_uint(rm),__float_as_uint(rm),false,false); rm=__builtin_fmaxf(__uint_as_float(rr[0]),__uint_as_float(rr[1])); } \
      resc=false; \
      if(__builtin_expect(__any(rm>(float)THRL),0)){ const float dl=__builtin_fmaxf(rm,0.f); mhat+=dl; \
        _Pragma("unroll") for(int r=0;r<16;++r){C0[r]-=dl;C1[r]-=dl;} \
        _Pragma("unroll") for(int r=0;r<16;++r)negm[r]=-mhat; asm volatile("":"+v"(negm)); \
        const float f=__builtin_amdgcn_exp2f(-dl); l_reg*=f; if(hi==0)wsf[r32]=f; resc=true; } } \
    SBAR(); \
    GAPB(o[0]=__builtin_amdgcn_mfma_f32_32x32x16_bf16(PAF(0),VFR(0),o[0],0,0,0), C0,0); \
    GAPB(o[1]=__builtin_amdgcn_mfma_f32_32x32x16_bf16(PAF(0),VFR(4),o[1],0,0,0), C0,4); \
    KRD(GL,0); GAPB(o[0]=__builtin_amdgcn_mfma_f32_32x32x16_bf16(PAF(1),VFR(1),o[0],0,0,0), C0,8); \
    KRD(GL,1); GAPB(o[1]=__builtin_amdgcn_mfma_f32_32x32x16_bf16(PAF(1),VFR(5),o[1],0,0,0), C0,12); \
    KRD(GL,2); GAPB(o[0]=__builtin_amdgcn_mfma_f32_32x32x16_bf16(PAF(2),VFR(2),o[0],0,0,0), C1,0); \
    KRD(GL,3); GAPB(o[1]=__builtin_amdgcn_mfma_f32_32x32x16_bf16(PAF(2),VFR(6),o[1],0,0,0), C1,4); \
    GAPB(o[0]=__builtin_amdgcn_mfma_f32_32x32x16_bf16(PAF(3),VFR(3),o[0],0,0,0), C1,8); \
    GAPB(o[1]=__builtin_amdgcn_mfma_f32_32x32x16_bf16(PAF(3),VFR(7),o[1],0,0,0), C1,12); \
    }while(0)
  int t=1;
  #undef CMASK
  #define CMASK(P0,P1,t) do{}while(0)
  for(;t+5<NT;t+=2){
    STEP(pB0,pB1,pA0,pA1,t,true,true,true);     WAIT_BAR(2); RESC(); ROT();
    STEP(pA0,pA1,pB0,pB1,t+1,true,true,true);   WAIT_BAR(2); RESC(); ROT();
  }
  #undef CMASK
  #define CMASK(P0,P1,t) do{int jb_=(t)-(NT-4); if(jb_>=0)cmask(P0,P1,jb_,qrel,hi);}while(0)
  #define ENDW(tt) do{ if((tt)+3<NT){WAIT_BAR(2);} else if((tt)+2<NT){WAIT_BAR(1);} else {WAIT_BAR(0);} }while(0)
  for(;t+1<NT;t+=2){
    STEP(pB0,pB1,pA0,pA1,t,(t+3<NT),(t+1<NT),(t+1<NT));       ENDW(t);   RESC(); ROT();
    STEP(pA0,pA1,pB0,pB1,t+1,(t+4<NT),(t+2<NT),(t+2<NT));     ENDW(t+1); RESC(); ROT();
  }
  STEP(pB0,pB1,pA0,pA1,NT-1,false,false,false); RESC();
  { float sacc=pB0[0]+pB0[1]; _Pragma("unroll") for(int r=2;r<16;++r)sacc+=pB0[r]; _Pragma("unroll") for(int r=0;r<16;++r)sacc+=pB1[r]; l_reg+=sacc;
    pw0=(u32x4){PKW(pB0,0),PKW(pB0,2),PKW(pB0,4),PKW(pB0,6)};pw1=(u32x4){PKW(pB0,8),PKW(pB0,10),PKW(pB0,12),PKW(pB0,14)};pw2=(u32x4){PKW(pB1,0),PKW(pB1,2),PKW(pB1,4),PKW(pB1,6)};pw3=(u32x4){PKW(pB1,8),PKW(pB1,10),PKW(pB1,12),PKW(pB1,14)};
    SBAR(); pv(o,vb0+sl_cur,PAF(0),PAF(1),PAF(2),PAF(3)); }
  #undef PKW
  #undef PAF
  #undef VFR
  #undef PIN
  #undef MX3
  #undef GAPA
  #undef GAPB
  #undef EX
  #undef VRD
  #undef KRD
  #undef STEP
  #undef ENDW
  {auto rr=__builtin_amdgcn_permlane32_swap(__float_as_uint(l_reg),__float_as_uint(l_reg),false,false);l_reg=__uint_as_float(rr[0])+__uint_as_float(rr[1]);}
  if(hi==0)wsf[32+r32]=l_reg;asm volatile("s_waitcnt lgkmcnt(0)":::"memory");
  float rli[16];
  #pragma unroll
  for(int r=0;r<16;++r)rli[r]=__builtin_amdgcn_rcpf(wsf[32+crow(r,hi)]);
  #pragma unroll
  for(int r=0;r<16;++r){o[0][r]*=rli[r];o[1][r]*=rli[r];}
  float*stA=stash+(size_t)(wid*32)*64+lane; float*stB=stash+(size_t)((8+wid)*32)*64+lane;
  if(p==0){
    #pragma unroll
    for(int k=0;k<32;++k)stA[k*64]=o[k>>4][k&15];
  }else if(p==2){
    #pragma unroll
    for(int k=0;k<32;++k)stB[k*64]=o[k>>4][k&15];
  }else if(p==1){
    #pragma unroll
    for(int k=0;k<32;++k)stA[k*64]=stA[k*64]-lam*o[k>>4][k&15];
  }else{
    f32x16 fa[2];
    #pragma unroll
    for(int k=0;k<32;++k){o[k>>4][k&15]=stB[k*64]-lam*o[k>>4][k&15]; fa[k>>4][k&15]=stA[k*64];}
    #pragma unroll
    for(int r=0;r<16;++r){
      float ss=fa[0][r]*fa[0][r]+fa[1][r]*fa[1][r]+o[0][r]*o[0][r]+o[1][r]*o[1][r];
      ss+=__shfl_xor(ss,1);ss+=__shfl_xor(ss,2);ss+=__shfl_xor(ss,4);ss+=__shfl_xor(ss,8);ss+=__shfl_xor(ss,16);
      const float rs=1.0f/sqrtf(ss*(1.0f/128.0f)+1e-5f);
      fa[0][r]*=rs;fa[1][r]*=rs;o[0][r]*=rs;o[1][r]*=rs;}
    bf16*stg=(bf16*)(shm+LDS_OST)+wid*2048;
    bf16*Gw=GO+(rowbase+q0+wid*QBLK)*DM+h*128;
    #pragma unroll
    for(int hv=0;hv<2;++hv){
      #pragma unroll
      for(int r=0;r<16;++r){const int orow=crow(r,hi);
        #pragma unroll
        for(int d0=0;d0<2;++d0)stg[orow*64+d0*32+r32]=__float2bfloat16(hv==0?fa[d0][r]:o[d0][r]);}
      asm volatile("s_waitcnt lgkmcnt(0)":::"memory");
      #pragma unroll
      for(int i=0;i<4;++i){const int row=i*8+(lane>>3),ch=lane&7; const u32x4 v=*(const u32x4*)(stg+row*64+ch*8);
        bf16*gp=Gw+(long)row*DM+hv*64+ch*8; const u32x4 gt=*(const u32x4*)gp;
        const float4 s0=*(const float4*)(subg+hv*64+ch*8), s1=*(const float4*)(subg+hv*64+ch*8+4);
        const float sg[8]={s0.x,s0.y,s0.z,s0.w,s1.x,s1.y,s1.z,s1.w}; float rr_[8];
        #pragma unroll
        for(int e=0;e<4;++e){ const unsigned vw=v[e], gw=gt[e];
          const float v0=__uint_as_float(vw<<16), v1=__uint_as_float(vw&0xffff0000u), g0=__uint_as_float(gw<<16), g1=__uint_as_float(gw&0xffff0000u);
          rr_[2*e]=v0*sg[2*e]*0.8f*g0/(1.0f+__expf(-g0)); rr_[2*e+1]=v1*sg[2*e+1]*0.8f*g1/(1.0f+__expf(-g1)); }
        u32x4 ov; ov[0]=cvtpk_s(rr_[0],rr_[1]); ov[1]=cvtpk_s(rr_[2],rr_[3]); ov[2]=cvtpk_s(rr_[4],rr_[5]); ov[3]=cvtpk_s(rr_[6],rr_[7]);
        *(u32x4*)gp=ov; }
      asm volatile("s_waitcnt lgkmcnt(0)":::"memory");
    }
  }
  asm volatile("s_waitcnt lgkmcnt(0)\n\ts_barrier":::"memory");
  #undef DMA_K
  #undef DMA_V
  #undef CMASK
  #undef START
  #undef RESC
  #undef ROT
}
constexpr int ATTN_LDS_BYTES=LDS_BYTES;
constexpr int K2_SLOT=8192, V2_SLOT=16384;
constexpr int L2_K=0, L2_V=3*K2_SLOT, L2_WS=L2_V+3*V2_SLOT, L2_OST=L2_WS+NW*64*4, LDS2_BYTES=L2_OST+NW*4096;
__device__ __forceinline__ void attn_unit2(int b,int h,int qb,int m,float lam,const bf16*Q,const bf16*__restrict__ K,const bf16*__restrict__ V,bf16*GO,const float*__restrict__ subg,float*stash,char*shm){
  int tid=threadIdx.x; asm volatile("":"+v"(tid)); const int lane=tid&63,r32=lane&31,hi=lane>>5; const int wid=__builtin_amdgcn_readfirstlane(tid>>6);
  const long rowbase=(long)b*SEQ; const int q0=qb*QB;
  const int qkcol=h*128+m*64, vcol=h*128;
  const bf16*Qw=Q+(rowbase+q0+wid*QBLK)*DM+qkcol;
  const bf16*Kh=K+rowbase*DM+qkcol,*Vh=V+rowbase*DM+vcol;
  const unsigned lds0=(unsigned)(uintptr_t)shm;
  float*wsf=(float*)(shm+L2_WS)+wid*64;
  const bf16*ksrc=Kh+(long)lane*DM+wid*8;
  const bf16*vsrc=Vh+(long)(16*(wid&3)+(lane>>2))*DM+(wid>>2)*32+(lane&3)*8;
  const unsigned kdst=lds0+L2_K+wid*1024, vdst=lds0+L2_V+wid*1024;
  #define DMA2(t,s) do{ const long go_=(long)(t)*KVBLK*DM; \
    glds16(ksrc+go_,(unsigned)__builtin_amdgcn_readfirstlane(kdst+(s)*K2_SLOT)); \
    glds16(vsrc+go_,(unsigned)__builtin_amdgcn_readfirstlane(vdst+(s)*V2_SLOT)); \
    glds16(vsrc+go_+64,(unsigned)__builtin_amdgcn_readfirstlane(vdst+(s)*V2_SLOT+8192)); }while(0)
  const int vb0=(int)(lds0+L2_V)+((lane>>4)&1)*32+(lane&3)*8+(4*hi+((lane&15)>>2))*64;
  const char*Kbase=shm+L2_K;
  const int NT=(q0+QB)/KVBLK;
  asm volatile("s_waitcnt vmcnt(0)":::"memory");
  bf16x8 qr[4];
  #pragma unroll
  for(int d0=0;d0<4;++d0)qr[d0]=*reinterpret_cast<const bf16x8*>(&Qw[(long)r32*DM+d0*16+hi*8]);
  asm volatile("":"+v"(qr[0]),"+v"(qr[1]),"+v"(qr[2]),"+v"(qr[3])::"memory");
  DMA2(0,0); DMA2(1,1);
  float mhat=0.f,l_reg=0.f; f32x16 o[4]; o[0]=f32x16{};o[1]=f32x16{};o[2]=f32x16{};o[3]=f32x16{}; f32x16 negm=f32x16{};
  const int qrel=wid*QBLK+r32;
  int slot=0;
  for(int t=0;t<NT;++t){
    if(t+1<NT){WAIT_BAR(3);}else{WAIT_BAR(0);}
    if(t+2<NT){ const int s2=(slot==0)?2:slot-1; DMA2(t+2,s2); }
    f32x16 p0,p1;
    qkt(p0,p1,Kbase+slot*K2_SLOT,qr,negm,r32,hi);
    { const int jb=t-(NT-4); if(jb>=0)cmask(p0,p1,jb,qrel,hi); }
    float rm=fmaxf(p0[0],p1[0]);
    #pragma unroll
    for(int r=1;r<16;++r){rm=fmaxf(rm,p0[r]);rm=fmaxf(rm,p1[r]);}
    { auto rr=__builtin_amdgcn_permlane32_swap(__float_as_uint(rm),__float_as_uint(rm),false,false); rm=fmaxf(__uint_as_float(rr[0]),__uint_as_float(rr[1])); }
    if(t==0){ mhat=rm;
      #pragma unroll
      for(int r=0;r<16;++r){p0[r]-=rm;p1[r]-=rm;negm[r]=-mhat;}
    }else if(__any(rm>8.0f)){ const float dl=fmaxf(rm,0.f); mhat+=dl;
      #pragma unroll
      for(int r=0;r<16;++r){p0[r]-=dl;p1[r]-=dl;negm[r]=-mhat;}
      const float f=__builtin_amdgcn_exp2f(-dl); l_reg*=f; if(hi==0)wsf[r32]=f;
      asm volatile("s_waitcnt lgkmcnt(0)":::"memory");
      #pragma unroll
      for(int r=0;r<16;++r){const float fr_=wsf[crow(r,hi)]; o[0][r]*=fr_;o[1][r]*=fr_;o[2][r]*=fr_;o[3][r]*=fr_;}
    }
    float sacc=0.f;
    #pragma unroll
    for(int r=0;r<16;++r){p0[r]=__builtin_amdgcn_exp2f(p0[r]);p1[r]=__builtin_amdgcn_exp2f(p1[r]);sacc+=p0[r]+p1[r];}
    l_reg+=sacc;
    u32x4 pw0,pw1,pw2,pw3;
    pw0=(u32x4){cvtpk_s(p0[0],p0[1]),cvtpk_s(p0[2],p0[3]),cvtpk_s(p0[4],p0[5]),cvtpk_s(p0[6],p0[7])};
    pw1=(u32x4){cvtpk_s(p0[8],p0[9]),cvtpk_s(p0[10],p0[11]),cvtpk_s(p0[12],p0[13]),cvtpk_s(p0[14],p0[15])};
    pw2=(u32x4){cvtpk_s(p1[0],p1[1]),cvtpk_s(p1[2],p1[3]),cvtpk_s(p1[4],p1[5]),cvtpk_s(p1[6],p1[7])};
    pw3=(u32x4){cvtpk_s(p1[8],p1[9]),cvtpk_s(p1[10],p1[11]),cvtpk_s(p1[12],p1[13]),cvtpk_s(p1[14],p1[15])};
    const int vb=vb0+slot*V2_SLOT;
    pv(o,vb,__builtin_bit_cast(bf16x8,pw0),__builtin_bit_cast(bf16x8,pw1),__builtin_bit_cast(bf16x8,pw2),__builtin_bit_cast(bf16x8,pw3));
    pv(o+2,vb+8192,__builtin_bit_cast(bf16x8,pw0),__builtin_bit_cast(bf16x8,pw1),__builtin_bit_cast(bf16x8,pw2),__builtin_bit_cast(bf16x8,pw3));
    slot=(slot==2)?0:slot+1;
  }
  #undef DMA2
  {auto rr=__builtin_amdgcn_permlane32_swap(__float_as_uint(l_reg),__float_as_uint(l_reg),false,false);l_reg=__uint_as_float(rr[0])+__uint_as_float(rr[1]);}
  if(hi==0)wsf[32+r32]=l_reg;asm volatile("s_waitcnt lgkmcnt(0)":::"memory");
  #pragma unroll
  for(int r=0;r<16;++r){const float rl=__builtin_amdgcn_rcpf(wsf[32+crow(r,hi)]); o[0][r]*=rl;o[1][r]*=rl;o[2][r]*=rl;o[3][r]*=rl;}
  float*st=stash+(size_t)(wid*64)*64+lane;
  if(m==0){
    #pragma unroll
    for(int k=0;k<64;++k)st[k*64]=o[k>>4][k&15];
  }else{
    #pragma unroll
    for(int k=0;k<64;++k)o[k>>4][k&15]=st[k*64]-lam*o[k>>4][k&15];
    #pragma unroll
    for(int r=0;r<16;++r){
      float ss=o[0][r]*o[0][r]+o[1][r]*o[1][r]+o[2][r]*o[2][r]+o[3][r]*o[3][r];
      ss+=__shfl_xor(ss,1);ss+=__shfl_xor(ss,2);ss+=__shfl_xor(ss,4);ss+=__shfl_xor(ss,8);ss+=__shfl_xor(ss,16);
      const float rs=1.0f/sqrtf(ss*(1.0f/128.0f)+1e-5f);
      o[0][r]*=rs;o[1][r]*=rs;o[2][r]*=rs;o[3][r]*=rs;}
    float*stg=(float*)(shm+L2_OST)+wid*1024;
    bf16*Gw=GO+(rowbase+q0+wid*QBLK)*DM+h*128;
    #pragma unroll
    for(int d0=0;d0<4;++d0){
      #pragma unroll
      for(int r=0;r<16;++r)stg[crow(r,hi)*32+r32]=o[d0][r];
      asm volatile("s_waitcnt lgkmcnt(0)":::"memory");
      #pragma unroll
      for(int i=0;i<2;++i){const int row=i*16+(lane>>2),ch=lane&3; const float4 va=*(const float4*)(stg+row*32+ch*8), vb_=*(const float4*)(stg+row*32+ch*8+4);
        bf16*gp=Gw+(long)row*DM+d0*32+ch*8; const u32x4 gt=*(const u32x4*)gp;
        const float4 s0=*(const float4*)(subg+d0*32+ch*8), s1=*(const float4*)(subg+d0*32+ch*8+4);
        const float vv[8]={va.x,va.y,va.z,va.w,vb_.x,vb_.y,vb_.z,vb_.w}; const float sg[8]={s0.x,s0.y,s0.z,s0.w,s1.x,s1.y,s1.z,s1.w}; float rr_[8];
        #pragma unroll
        for(int e=0;e<4;++e){ const unsigned gw=gt[e]; const float g0=__uint_as_float(gw<<16), g1=__uint_as_float(gw&0xffff0000u);
          rr_[2*e]=vv[2*e]*sg[2*e]*0.8f*g0/(1.0f+__expf(-g0)); rr_[2*e+1]=vv[2*e+1]*sg[2*e+1]*0.8f*g1/(1.0f+__expf(-g1)); }
        u32x4 ov; ov[0]=cvtpk_s(rr_[0],rr_[1]); ov[1]=cvtpk_s(rr_[2],rr_[3]); ov[2]=cvtpk_s(rr_[4],rr_[5]); ov[3]=cvtpk_s(rr_[6],rr_[7]);
        *(u32x4*)gp=ov; }
      asm volatile("s_waitcnt lgkmcnt(0)":::"memory");
    }
  }
  asm volatile("s_waitcnt lgkmcnt(0)\n\ts_barrier":::"memory");
}
template<int THRL> __device__ __forceinline__ void attn_unit3(int b,int h,int qb,int m,float lam,const bf16*Q,const bf16*__restrict__ K,const bf16*__restrict__ V,bf16*GO,const float*__restrict__ subg,float*stash,char*shm){
  int tid=threadIdx.x; asm volatile("":"+v"(tid)); const int lane=tid&63,r32=lane&31,hi=lane>>5; const int wid=__builtin_amdgcn_readfirstlane(tid>>6);
  const long rowbase=(long)b*SEQ; const int q0=qb*QB;
  const int qkcol=h*128+m*64, vcol=h*128;
  const bf16*Qw=Q+(rowbase+q0+wid*QBLK)*DM+qkcol;
  const bf16*Kh=K+rowbase*DM+qkcol,*Vh=V+rowbase*DM+vcol;
  const unsigned lds0=(unsigned)(uintptr_t)shm;
  float*wsf=(float*)(shm+L2_WS)+wid*64;
  const bf16*ksrc=Kh+(long)lane*DM+wid*8;
  const bf16*vsrc=Vh+(long)(16*(wid&3)+(lane>>2))*DM+(wid>>2)*32+(lane&3)*8;
  const unsigned kdst=lds0+L2_K+wid*1024, vdst=lds0+L2_V+wid*1024;
  #define DMA_K(t,slot) glds16(ksrc+(long)(t)*KVBLK*DM,(unsigned)__builtin_amdgcn_readfirstlane(kdst+(slot)))
  #define DMA_V(t,slot) do{ glds16(vsrc+(long)(t)*KVBLK*DM,(unsigned)__builtin_amdgcn_readfirstlane(vdst+2*(slot))); glds16(vsrc+(long)(t)*KVBLK*DM+64,(unsigned)__builtin_amdgcn_readfirstlane(vdst+2*(slot)+8192)); }while(0)
  const int vb0=(int)(lds0+L2_V)+((lane>>4)&1)*32+(lane&3)*8+(4*hi+((lane&15)>>2))*64;
  const char*Kbase=shm+L2_K; bf16x8 kf[8];
  const lds_cptr shm3=(lds_cptr)shm; const lds_cptr kp0=shm3+L2_K+hi*1024+r32*16; const lds_cptr vp0=shm3+L2_V+((lane>>4)&1)*32+(lane&3)*8+(4*hi+((lane&15)>>2))*64;
  const int NT=(q0+QB)/KVBLK;
  asm volatile("s_waitcnt vmcnt(0)":::"memory");
  DMA_K(0,0);DMA_V(0,0);DMA_K(1,SLOTB);
  bf16x8 qr[4];
  #pragma unroll
  for(int d0=0;d0<4;++d0)qr[d0]=*reinterpret_cast<const bf16x8*>(&Qw[(long)r32*DM+d0*16+hi*8]);
  const lds_cptr qp=shm3+L2_OST+wid*4096+lane*16;
  #define QLD(j) (*(const __attribute__((address_space(3))) bf16x8*)(qp+(j)*1024))
  float mhat=0.f,l_reg=0.f;f32x16 o[4];o[0]=f32x16{};o[1]=f32x16{};o[2]=f32x16{};o[3]=f32x16{};
  const int qrel=wid*QBLK+r32;
  #define CMASK(P0,P1,t) do{int jb_=(t)-(NT-4); if(jb_>=0)cmask(P0,P1,jb_,qrel,hi);}while(0)
  bool resc=false;
  #define START(P0,P1) do{ const float rm=rowmax(P0,P1); resc=false; \
    { const float dl=rm; mhat=fadd_s(mhat,dl); \
      _Pragma("unroll") for(int r=0;r<16;++r){P0[r]=fsub_s(P0[r],dl);P1[r]=fsub_s(P1[r],dl);} \
      } \
    _Pragma("unroll") for(int r=0;r<16;++r)P0[r]=__builtin_amdgcn_exp2f(P0[r]); }while(0)
  #define RESC() do{ if(resc){ asm volatile("s_waitcnt lgkmcnt(0)":::"memory"); \
      _Pragma("unroll") for(int r=0;r<16;++r){const float f_=wsf[crow(r,hi)]; o[0][r]*=f_;o[1][r]*=f_;o[2][r]*=f_;o[3][r]*=f_;} } }while(0)
  f32x16 pA0,pA1,pB0,pB1;
  int sl_prev=0,sl_cur=0,sl_next=SLOTB;
  #define ROT() do{sl_prev=sl_cur;sl_cur=sl_next;sl_next=(sl_next==(NSLOT-1)*SLOTB)?0:sl_next+SLOTB;}while(0)
  DMA_K(2,2*SLOTB);
  WAIT_BAR(4);
  qkt(pA0,pA1,Kbase,qr,f32x16{},r32,hi);asm volatile("s_nop 15\n\ts_nop 7":"+v"(pA0),"+v"(pA1));CMASK(pA0,pA1,0);
  START(pA0,pA1);
  _Pragma("unroll") for(int r=0;r<16;++r)pA1[r]=__builtin_amdgcn_exp2f(pA1[r]);
  #pragma unroll
  for(int d0=0;d0<4;++d0)*(__attribute__((address_space(3))) bf16x8*)(qp+d0*1024)=qr[d0];
  WAIT_BAR(0);
  DMA_K(3,0);DMA_V(1,SLOTB);
  ROT();
  kload8(kf,kp0+sl_cur);
  WAIT_BAR(3);
  s16x4 vlo[8],vhi[8],wlo[8],whi[8]; u32x4 pw0,pw1,pw2,pw3;
  #define PKW(P,B) cvtpk_s(P[B],P[B+1])
  #define PAF(k) __builtin_bit_cast(bf16x8,pw##k)
  #define VFR(i) (bf16x8){vlo[i][0],vlo[i][1],vlo[i][2],vlo[i][3],vhi[i][0],vhi[i][1],vhi[i][2],vhi[i][3]}
  #define PIN(x) asm volatile("":"+v"(x))
  #define MX3(a,b,c) __builtin_fmaxf(__builtin_fmaxf((a),(b)),(c))
  #define GAPA(MF,A0,A1,A2,A3,W0,W1,PW) do{ MF; sacc+=A0; sacc+=A1; sacc+=A2; sacc+=A3; PIN(sacc); W0; W1; PIN(PW); SBAR(); }while(0)
  #define EX(v) __builtin_amdgcn_exp2f(v)
  #define GAPB(MF,X,B) do{ MF; X[B]=EX(X[B]); X[B+1]=EX(X[B+1]); X[B+2]=EX(X[B+2]); X[B+3]=EX(X[B+3]); PIN(X); SBAR(); }while(0)
  #define GAPB2(MF,X,B) do{ MF; X[B]=EX(X[B]); X[B+1]=EX(X[B+1]); PIN(X); SBAR(); }while(0)
  #define WFR(i) (bf16x8){wlo[i][0],wlo[i][1],wlo[i][2],wlo[i][3],whi[i][0],whi[i][1],whi[i][2],whi[i][3]}
  #define WRD(i) do{ wlo[i]=vtr(vp_+(8192+((i)>>2)*4096+((i)&3)*1024)); whi[i]=vtr(vp_+(8192+((i)>>2)*4096+((i)&3)*1024+512)); }while(0)
  #define VRD(i) do{ vlo[i]=vtr(vp_+(((i)>>2)*4096+((i)&3)*1024)); vhi[i]=vtr(vp_+(((i)>>2)*4096+((i)&3)*1024+512)); }while(0)
  #define KRD(G,j) do{ if(G){ kload2(kf,kp0+sl_next,j); SBAR(); } }while(0)
  #define STEP(C0,C1,P0,P1,t,GK,GV,GL) do{ SBAR(); \
    const lds_cptr vp_=vp0+2*sl_prev; \
    bf16x8 qa=QLD(0),qb=QLD(1); VRD(0); SBAR(); float sacc=(P0[0]+P0[1]); \
    GAPA(C0=__builtin_amdgcn_mfma_f32_32x32x16_bf16(kf[0],qa,f32x16{},0,0,0), P0[2],P0[3],P0[4],P0[5],     pw0[0]=PKW(P0,0), pw0[1]=PKW(P0,2), pw0); \
    VRD(4); SBAR(); GAPA(C1=__builtin_amdgcn_mfma_f32_32x32x16_bf16(kf[1],qa,f32x16{},0,0,0), P0[6],P0[7],P0[8],P0[9],     pw0[2]=PKW(P0,4), pw0[3]=PKW(P0,6), pw0); \
    qa=QLD(2); VRD(1); SBAR(); GAPA(C0=__builtin_amdgcn_mfma_f32_32x32x16_bf16(kf[2],qb,C0,0,0,0),   P0[10],P0[11],P0[12],P0[13], pw1[0]=PKW(P0,8), pw1[1]=PKW(P0,10), pw1); \
    VRD(5); SBAR(); GAPA(C1=__builtin_amdgcn_mfma_f32_32x32x16_bf16(kf[3],qb,C1,0,0,0),   P0[14],P0[15],P1[0],P1[1],   pw1[2]=PKW(P0,12),pw1[3]=PKW(P0,14), pw1); \
    qb=QLD(3); VRD(2); SBAR(); GAPA(C0=__builtin_amdgcn_mfma_f32_32x32x16_bf16(kf[4],qa,C0,0,0,0),   P1[2],P1[3],P1[4],P1[5],     pw2[0]=PKW(P1,0), pw2[1]=PKW(P1,2), pw2); \
    VRD(6); SBAR(); GAPA(C1=__builtin_amdgcn_mfma_f32_32x32x16_bf16(kf[5],qa,C1,0,0,0),   P1[6],P1[7],P1[8],P1[9],     pw2[2]=PKW(P1,4), pw2[3]=PKW(P1,6), pw2); \
    VRD(3); SBAR(); GAPA(C0=__builtin_amdgcn_mfma_f32_32x32x16_bf16(kf[6],qb,C0,0,0,0),   P1[10],P1[11],P1[12],P1[13], pw3[0]=PKW(P1,8), pw3[1]=PKW(P1,10), pw3); \
    VRD(7); SBAR(); GAPA(C1=__builtin_amdgcn_mfma_f32_32x32x16_bf16(kf[7],qb,C1,0,0,0),   P1[14],P1[15],0.f,0.f,       pw3[2]=PKW(P1,12),pw3[3]=PKW(P1,14), pw3); \
    l_reg+=sacc; \
    _Pragma("unroll") for(int r=0;r<16;++r){C0[r]-=mhat;C1[r]-=mhat;} \
    if(GK){DMA_K((t)+3,sl_cur);} if(GV){DMA_V((t)+1,sl_next);} \
    CMASK(C0,C1,t); \
    { float a=MX3(C0[0],C0[1],C1[0]),b=MX3(C0[2],C0[3],C1[1]); a=MX3(a,C1[2],C1[3]); \
      _Pragma("unroll") for(int r=4;r<16;r+=4){a=MX3(a,C0[r],C0[r+1]);b=MX3(b,C0[r+2],C0[r+3]);a=MX3(a,C1[r],C1[r+1]);b=MX3(b,C1[r+2],C1[r+3]);} \
      float rm=__builtin_fmaxf(a,b); { auto rr=__builtin_amdgcn_permlane32_swap(__float_as_uint(rm),__float_as_uint(rm),false,false); rm=__builtin_fmaxf(__uint_as_float(rr[0]),__uint_as_float(rr[1])); } \
      resc=false; \
      if(__builtin_expect(__any(rm>(float)THRL),0)){ const float dl=__builtin_fmaxf(rm,0.f); mhat+=dl; \
        _Pragma("unroll") for(int r=0;r<16;++r){C0[r]-=dl;C1[r]-=dl;} \
        const float f=__builtin_amdgcn_exp2f(-dl); l_reg*=f; if(hi==0)wsf[r32]=f; resc=true; } } \
    SBAR(); \
    GAPB2(o[0]=__builtin_amdgcn_mfma_f32_32x32x16_bf16(PAF(0),VFR(0),o[0],0,0,0), C0,0); \
    GAPB2(o[1]=__builtin_amdgcn_mfma_f32_32x32x16_bf16(PAF(0),VFR(4),o[1],0,0,0), C0,2); \
    KRD(GL,0); GAPB2(o[0]=__builtin_amdgcn_mfma_f32_32x32x16_bf16(PAF(1),VFR(1),o[0],0,0,0), C0,4); \
    KRD(GL,1); GAPB2(o[1]=__builtin_amdgcn_mfma_f32_32x32x16_bf16(PAF(1),VFR(5),o[1],0,0,0), C0,6); \
    KRD(GL,2); WRD(0); SBAR(); GAPB2(o[0]=__builtin_amdgcn_mfma_f32_32x32x16_bf16(PAF(2),VFR(2),o[0],0,0,0), C0,8); \
    KRD(GL,3); WRD(4); SBAR(); GAPB2(o[1]=__builtin_amdgcn_mfma_f32_32x32x16_bf16(PAF(2),VFR(6),o[1],0,0,0), C0,10); \
    WRD(1); SBAR(); GAPB2(o[0]=__builtin_amdgcn_mfma_f32_32x32x16_bf16(PAF(3),VFR(3),o[0],0,0,0), C0,12); \
    WRD(5); SBAR(); GAPB2(o[1]=__builtin_amdgcn_mfma_f32_32x32x16_bf16(PAF(3),VFR(7),o[1],0,0,0), C0,14); \
    WRD(2); SBAR(); GAPB2(o[2]=__builtin_amdgcn_mfma_f32_32x32x16_bf16(PAF(0),WFR(0),o[2],0,0,0), C1,0); \
    WRD(6); SBAR(); GAPB2(o[3]=__builtin_amdgcn_mfma_f32_32x32x16_bf16(PAF(0),WFR(4),o[3],0,0,0), C1,2); \
    WRD(3); SBAR(); GAPB2(o[2]=__builtin_amdgcn_mfma_f32_32x32x16_bf16(PAF(1),WFR(1),o[2],0,0,0), C1,4); \
    WRD(7); SBAR(); GAPB2(o[3]=__builtin_amdgcn_mfma_f32_32x32x16_bf16(PAF(1),WFR(5),o[3],0,0,0), C1,6); \
    GAPB2(o[2]=__builtin_amdgcn_mfma_f32_32x32x16_bf16(PAF(2),WFR(2),o[2],0,0,0), C1,8); \
    GAPB2(o[3]=__builtin_amdgcn_mfma_f32_32x32x16_bf16(PAF(2),WFR(6),o[3],0,0,0), C1,10); \
    GAPB2(o[2]=__builtin_amdgcn_mfma_f32_32x32x16_bf16(PAF(3),WFR(3),o[2],0,0,0), C1,12); \
    GAPB2(o[3]=__builtin_amdgcn_mfma_f32_32x32x16_bf16(PAF(3),WFR(7),o[3],0,0,0), C1,14); \
    }while(0)
  int t=1;
  #undef CMASK
  #define CMASK(P0,P1,t) do{}while(0)
  for(;t+5<NT;t+=2){
    STEP(pB0,pB1,pA0,pA1,t,true,true,true);     WAIT_BAR(3); RESC(); ROT();
    STEP(pA0,pA1,pB0,pB1,t+1,true,true,true);   WAIT_BAR(3); RESC(); ROT();
  }
  #undef CMASK
  #define CMASK(P0,P1,t) do{int jb_=(t)-(NT-4); if(jb_>=0)cmask(P0,P1,jb_,qrel,hi);}while(0)
  #define ENDW(tt) do{ if((tt)+3<NT){WAIT_BAR(3);} else if((tt)+2<NT){WAIT_BAR(2);} else {WAIT_BAR(0);} }while(0)
  for(;t+1<NT;t+=2){
    STEP(pB0,pB1,pA0,pA1,t,(t+3<NT),(t+1<NT),(t+1<NT));       ENDW(t);   RESC(); ROT();
    STEP(pA0,pA1,pB0,pB1,t+1,(t+4<NT),(t+2<NT),(t+2<NT));     ENDW(t+1); RESC(); ROT();
  }
  STEP(pB0,pB1,pA0,pA1,NT-1,false,false,false); RESC();
  { float sacc=pB0[0]+pB0[1]; _Pragma("unroll") for(int r=2;r<16;++r)sacc+=pB0[r]; _Pragma("unroll") for(int r=0;r<16;++r)sacc+=pB1[r]; l_reg+=sacc;
    pw0=(u32x4){PKW(pB0,0),PKW(pB0,2),PKW(pB0,4),PKW(pB0,6)};pw1=(u32x4){PKW(pB0,8),PKW(pB0,10),PKW(pB0,12),PKW(pB0,14)};pw2=(u32x4){PKW(pB1,0),PKW(pB1,2),PKW(pB1,4),PKW(pB1,6)};pw3=(u32x4){PKW(pB1,8),PKW(pB1,10),PKW(pB1,12),PKW(pB1,14)};
    SBAR(); pv(o,vb0+2*sl_cur,PAF(0),PAF(1),PAF(2),PAF(3)); pv(o+2,vb0+2*sl_cur+8192,PAF(0),PAF(1),PAF(2),PAF(3)); }
  #undef PKW
  #undef PAF
  #undef VFR
  #undef PIN
  #undef MX3
  #undef GAPA
  #undef GAPB
  #undef GAPB2
  #undef QLD
  #undef WFR
  #undef WRD
  #undef EX
  #undef VRD
  #undef KRD
  #undef STEP
  #undef ENDW
  {auto rr=__builtin_amdgcn_permlane32_swap(__float_as_uint(l_reg),__float_as_uint(l_reg),false,false);l_reg=__uint_as_float(rr[0])+__uint_as_float(rr[1]);}
  if(hi==0)wsf[32+r32]=l_reg;asm volatile("s_waitcnt lgkmcnt(0)":::"memory");
  #pragma unroll
  for(int r=0;r<16;++r){const float rl=__builtin_amdgcn_rcpf(wsf[32+crow(r,hi)]); o[0][r]*=rl;o[1][r]*=rl;o[2][r]*=rl;o[3][r]*=rl;}
  float*st=stash+(size_t)(wid*64)*64+lane;
  if(m==0){
    #pragma unroll
    for(int k=0;k<64;++k)st[k*64]=o[k>>4][k&15];
  }else{
    #pragma unroll
    for(int k=0;k<64;++k)o[k>>4][k&15]=st[k*64]-lam*o[k>>4][k&15];
    #pragma unroll
    for(int r=0;r<16;++r){
      float ss=o[0][r]*o[0][r]+o[1][r]*o[1][r]+o[2][r]*o[2][r]+o[3][r]*o[3][r];
      ss+=__shfl_xor(ss,1);ss+=__shfl_xor(ss,2);ss+=__shfl_xor(ss,4);ss+=__shfl_xor(ss,8);ss+=__shfl_xor(ss,16);
      const float rs=1.0f/sqrtf(ss*(1.0f/128.0f)+1e-5f);
      o[0][r]*=rs;o[1][r]*=rs;o[2][r]*=rs;o[3][r]*=rs;}
    float*stg=(float*)(shm+L2_OST)+wid*1024;
    bf16*Gw=GO+(rowbase+q0+wid*QBLK)*DM+h*128;
    #pragma unroll
    for(int d0=0;d0<4;++d0){
      #pragma unroll
      for(int r=0;r<16;++r)stg[crow(r,hi)*32+r32]=o[d0][r];
      asm volatile("s_waitcnt lgkmcnt(0)":::"memory");
      #pragma unroll
      for(int i=0;i<2;++i){const int row=i*16+(lane>>2),ch=lane&3; const float4 va=*(const float4*)(stg+row*32+ch*8), vb_=*(const float4*)(stg+row*32+ch*8+4);
        bf16*gp=Gw+(long)row*DM+d0*32+ch*8; const u32x4 gt=*(const u32x4*)gp;
        const float4 s0=*(const float4*)(subg+d0*32+ch*8), s1=*(const float4*)(subg+d0*32+ch*8+4);
        const float vv[8]={va.x,va.y,va.z,va.w,vb_.x,vb_.y,vb_.z,vb_.w}; const float sg[8]={s0.x,s0.y,s0.z,s0.w,s1.x,s1.y,s1.z,s1.w}; float rr_[8];
        #pragma unroll
        for(int e=0;e<4;++e){ const unsigned gw=gt[e]; const float g0=__uint_as_float(gw<<16), g1=__uint_as_float(gw&0xffff0000u);
          rr_[2*e]=vv[2*e]*sg[2*e]*0.8f*g0/(1.0f+__expf(-g0)); rr_[2*e+1]=vv[2*e+1]*sg[2*e+1]*0.8f*g1/(1.0f+__expf(-g1)); }
        u32x4 ov; ov[0]=cvtpk_s(rr_[0],rr_[1]); ov[1]=cvtpk_s(rr_[2],rr_[3]); ov[2]=cvtpk_s(rr_[4],rr_[5]); ov[3]=cvtpk_s(rr_[6],rr_[7]);
        *(u32x4*)gp=ov; }
      asm volatile("s_waitcnt lgkmcnt(0)":::"memory");
    }
  }
  asm volatile("s_waitcnt lgkmcnt(0)\n\ts_barrier":::"memory");
  #undef DMA_K
  #undef DMA_V
  #undef CMASK
  #undef START
  #undef RESC
  #undef ROT
}
#undef SBAR
#undef WAIT_BAR
}
#ifndef PG8_SP2
#define PG8_SP2 true
#endif
#ifndef PG8_ALIGN
#define PG8_ALIGN true
#endif
#ifndef ATTN_SIMPLE
#define ATTN_UNIT attn_unit3<8>
#else
#define ATTN_UNIT attn_unit2
#endif
#include <hip/hip_cooperative_groups.h>
namespace cg = cooperative_groups;
#define LAS __attribute__((address_space(3)))
#define GAS __attribute__((address_space(1)))
typedef unsigned short bf16;
typedef unsigned v4u __attribute__((ext_vector_type(4)));
typedef unsigned v2u __attribute__((ext_vector_type(2)));
typedef float f32x4 __attribute__((ext_vector_type(4)));
typedef short bf16x8 __attribute__((ext_vector_type(8)));
#define LDS_WAIT() asm volatile("s_waitcnt lgkmcnt(0)" ::: "memory")
constexpr int NWAVES = 8;
constexpr int BATCH = 8, SEQ = 4096, D = 1024, M = BATCH * SEQ, NPROJ = 8192;
constexpr float LN_EPS = 1e-5f;
constexpr size_t MiB = 1u << 20;
constexpr size_t WS_WIN = 2 * MiB, WS_WAP = 18 * MiB, WS_WRP = 20 * MiB, WS_WOUT = 22 * MiB, WS_ROPE = 24 * MiB;
constexpr size_t WS_S0 = 32 * MiB, SLOT = 64 * MiB;
constexpr size_t WS_STASH = 480 * MiB, WS_END = 512 * MiB;
constexpr int RING_BYTES = 131072, LDS_BYTES = 147456;
static_assert(attn_body::LDS_BYTES <= RING_BYTES && attn_body::LDS2_BYTES <= RING_BYTES && pg8::STAGE_BYTES <= RING_BYTES, "LDS map");

__device__ __forceinline__ unsigned f2bf(float f) { unsigned u = __builtin_bit_cast(unsigned, f); return (u + 0x7fffu + ((u >> 16) & 1u)) >> 16; }
__device__ __forceinline__ unsigned pk2(float lo, float hi) { return f2bf(lo) | (f2bf(hi) << 16); }
__device__ __forceinline__ float bfu(unsigned short h) { return __builtin_bit_cast(float, (unsigned)h << 16); }
__device__ __forceinline__ float wave_sum(float v) {
#pragma unroll
    for (int o = 1; o < 64; o <<= 1) v += __shfl_xor(v, o);
    return v;
}
__device__ __forceinline__ void p0_transpose_item(const float* W, int K, int N, bf16* WT, LAS float* scr, int item, int lane) {
    const int nblk = N / 32, kb = item / nblk, nb = item % nblk, k0 = 64 * kb, n0 = 32 * nb;
#pragma unroll 8
    for (int i = 0; i < 32; ++i) { const int kk = 2 * i + (lane >> 5); scr[kk * 33 + (lane & 31)] = W[(size_t)(k0 + kk) * N + n0 + (lane & 31)]; }
    LDS_WAIT(); asm volatile("" ::: "memory");
    const int c = lane & 7;
#pragma unroll
    for (int j = 0; j < 4; ++j) { const int n = (lane >> 3) + 8 * j; const LAS float* s = scr + (8 * c) * 33 + n;
        v4u o; o.x = pk2(s[0 * 33], s[1 * 33]); o.y = pk2(s[2 * 33], s[3 * 33]); o.z = pk2(s[4 * 33], s[5 * 33]); o.w = pk2(s[6 * 33], s[7 * 33]);
        *(GAS v4u*)(WT + (size_t)(n0 + n) * K + k0 + 8 * c) = o; }
    LDS_WAIT(); asm volatile("" ::: "memory");
}

struct Args { const float* in[20]; float* out; unsigned char* ws; };

__device__ __forceinline__ void p0_prologue(const float* x, const float* w_in, const float* w_ap, const float* w_rp, const float* w_out, bf16* Win_t, bf16* Wap_t, bf16* Wrp_t, bf16* Wout_t, bf16* XB, float* rope,
                                            LAS unsigned char* lds, int vcu, int G, int wave, int lane) {
    LAS float* scr = (LAS float*)(lds + wave * 16384);
    const int gw = vcu * NWAVES + wave, NGW = G * NWAVES;
    constexpr int I_IN = (D / 64) * (NPROJ / 32), I_SQ = (D / 64) * (D / 32);
    constexpr int NITEMS = I_IN + 3 * I_SQ;
    for (int it = gw; it < NITEMS; it += NGW) {
        int r = it;
        if (r < I_IN) { p0_transpose_item(w_in, D, NPROJ, Win_t, scr, r, lane); continue; } r -= I_IN;
        if (r < I_SQ) { p0_transpose_item(w_ap, D, D, Wap_t, scr, r, lane); continue; } r -= I_SQ;
        if (r < I_SQ) { p0_transpose_item(w_rp, D, D, Wrp_t, scr, r, lane); continue; } r -= I_SQ;
        p0_transpose_item(w_out, D, D, Wout_t, scr, r, lane);
    }
    for (int m = gw; m < M; m += NGW) {
        const GAS f32x4* xr = (const GAS f32x4*)(x + (size_t)m * D) + lane;
        GAS v2u* o8 = (GAS v2u*)(XB + (size_t)m * D) + lane;
#pragma unroll
        for (int j = 0; j < 4; ++j) { const f32x4 v = xr[64 * j]; v2u w; w.x = pk2(v.x, v.y); w.y = pk2(v.z, v.w); o8[64 * j] = w; }
    }
    for (int e = gw * 64 + lane; e < SEQ * 8; e += NGW * 64) {
        const int pos = e >> 3, j = e & 7;
        const float inv = j == 0 ? 1.0f : j == 1 ? 0.1939227432012558f : j == 2 ? 0.03760603070259094f : j == 3 ? 0.007292664609849453f : j == 4 ? 0.0014142135623842478f
                        : j == 5 ? 0.00027424818836152554f : j == 6 ? 5.318296098266728e-05f : 1.0313386155758053e-05f;
        const float angf = (float)pos * inv;
        const double a = (double)angf, kk = __builtin_rint(a * 0.15915494309189535), r = a - kk * 6.283185307179586;
        const double x2 = r * r; double ts = r, tc = 1.0, sn = r, cs = 1.0;
#pragma unroll
        for (int n = 1; n <= 14; ++n) { tc *= -x2 * (1.0 / (double)((2 * n - 1) * (2 * n))); cs += tc; ts *= -x2 * (1.0 / (double)((2 * n) * (2 * n + 1))); sn += ts; }
        rope[pos * 16 + j] = (float)cs; rope[pos * 16 + 8 + j] = (float)sn;
    }
}

constexpr int RN_A = 0, RN_XCF = 34816, RN_AL = 51200, RN_UL = 68096, RN_SP = 84992, RN_SH = 87040, RN_CARRY = 89088;
__device__ __forceinline__ void rnn_unit(int b, int n, int q, const bf16* XR, bf16* GH, bf16* HO, const float* conv_w, const float* conv_b, const float* w_a, const float* b_a, const float* w_x, const float* b_x,
                                         const float* lru_lambda, LAS unsigned char* lds) {
    int tid = threadIdx.x; asm volatile("" : "+v"(tid)); const int lane = tid & 63, wave = __builtin_amdgcn_readfirstlane(tid >> 6);
    const int d0 = q * 32, chb = n * 128;
    const int c8 = tid & 15, tg = tid >> 4;
    float cw[4][8], cb[8];
#pragma unroll
    for (int e = 0; e < 8; ++e) { cb[e] = conv_b[chb + c8 * 8 + e];
#pragma unroll
        for (int j = 0; j < 4; ++j) cw[j][e] = conv_w[j * 1024 + chb + c8 * 8 + e]; }
    const int fr = lane & 15, quad = lane >> 4;
    bf16x8 bfr[4][4];
#pragma unroll
    for (int nt = 0; nt < 4; ++nt) { const float* Wg = (nt < 2 ? w_a : w_x) + (size_t)n * 16384 + d0 + (nt & 1) * 16 + fr;
#pragma unroll
        for (int ks = 0; ks < 4; ++ks) { bf16x8 f;
#pragma unroll
            for (int j = 0; j < 8; ++j) f[j] = (short)f2bf(Wg[(size_t)(ks * 32 + quad * 8 + j) * 128]);
            bfr[nt][ks] = f; } }
    float ba[2], bx[2], sp[2];
#pragma unroll
    for (int h2 = 0; h2 < 2; ++h2) { const int ch = chb + d0 + h2 * 16 + fr; ba[h2] = b_a[ch]; bx[h2] = b_x[ch]; sp[h2] = log1pf(__expf(-lru_lambda[ch])); }
    const int dl = tid & 31, seg = tid >> 5;
    LAS unsigned char* A_l = lds + RN_A; LAS float* xcf = (LAS float*)(lds + RN_XCF); LAS float* aL = (LAS float*)(lds + RN_AL); LAS float* uL = (LAS float*)(lds + RN_UL);
    LAS float* sP = (LAS float*)(lds + RN_SP); LAS float* sH = (LAS float*)(lds + RN_SH); LAS float* carry = (LAS float*)(lds + RN_CARRY);
    if (tid < 64) carry[tid] = 0.f;
    const size_t rowbase = (size_t)b * SEQ;
    v4u raw[7];
#pragma unroll
    for (int i = 0; i < 7; ++i) { const int tp = tg * 4 - 3 + i; raw[i] = (v4u){0u, 0u, 0u, 0u}; if (tp >= 0) raw[i] = *(const GAS v4u*)(XR + (rowbase + tp) * 1024 + chb + c8 * 8); }
    for (int ck = 0; ck < SEQ / 128; ++ck) {
        const int t0 = ck * 128;
        {
            float xr[7][8];
#pragma unroll
            for (int i = 0; i < 7; ++i) { xr[i][0] = pg8::bf_lo(raw[i].x); xr[i][1] = pg8::bf_hi(raw[i].x); xr[i][2] = pg8::bf_lo(raw[i].y); xr[i][3] = pg8::bf_hi(raw[i].y);
                                          xr[i][4] = pg8::bf_lo(raw[i].z); xr[i][5] = pg8::bf_hi(raw[i].z); xr[i][6] = pg8::bf_lo(raw[i].w); xr[i][7] = pg8::bf_hi(raw[i].w); }
#pragma unroll
            for (int tl = 0; tl < 4; ++tl) { float xc[8];
#pragma unroll
                for (int e = 0; e < 8; ++e) { float v = cb[e];
#pragma unroll
                    for (int j = 0; j < 4; ++j) v += cw[j][e] * xr[tl + j][e];
                    xc[e] = v; }
                const int t = tg * 4 + tl;
                v4u w; w.x = pk2(xc[0], xc[1]); w.y = pk2(xc[2], xc[3]); w.z = pk2(xc[4], xc[5]); w.w = pk2(xc[6], xc[7]);
                *(LAS v4u*)(A_l + t * 272 + c8 * 16) = w;
                if ((c8 >> 2) == q) { LAS f32x4* xp = (LAS f32x4*)(xcf + t * 32 + (c8 & 3) * 8); xp[0] = (f32x4){xc[0], xc[1], xc[2], xc[3]}; xp[1] = (f32x4){xc[4], xc[5], xc[6], xc[7]}; }
            }
        }
        if (ck + 1 < SEQ / 128) {
#pragma unroll
            for (int i = 0; i < 7; ++i) { const int tp = t0 + 128 + tg * 4 - 3 + i; raw[i] = *(const GAS v4u*)(XR + (rowbase + tp) * 1024 + chb + c8 * 8); }
        }
        const size_t goff = (rowbase + t0 + seg * 8) * 1024 + chb + d0 + dl; const bf16* gp = GH + goff; bf16* hp = HO + goff;
        unsigned short gv[8];
#pragma unroll
        for (int i = 0; i < 8; ++i) gv[i] = gp[(size_t)i * 1024];
        __syncthreads();
        f32x4 acc[4];
#pragma unroll
        for (int nt = 0; nt < 4; ++nt) acc[nt] = (f32x4){0.f, 0.f, 0.f, 0.f};
#pragma unroll
        for (int ks = 0; ks < 4; ++ks) { const bf16x8 af = *(const LAS bf16x8*)(A_l + (wave * 16 + fr) * 272 + ks * 64 + quad * 16);
#pragma unroll
            for (int nt = 0; nt < 4; ++nt) acc[nt] = __builtin_amdgcn_mfma_f32_16x16x32_bf16(af, bfr[nt][ks], acc[nt], 0, 0, 0); }
#pragma unroll
        for (int h2 = 0; h2 < 2; ++h2)
#pragma unroll
            for (int j = 0; j < 4; ++j) { const int t = wave * 16 + quad * 4 + j, cl = h2 * 16 + fr;
                const float r = 1.f / (1.f + __expf(-(acc[h2][j] + ba[h2]))), ig = 1.f / (1.f + __expf(-(acc[2 + h2][j] + bx[h2])));
                const float la = -8.f * r * sp[h2], av = __expf(la), y = 2.f * la;
                const float em1 = y * (1.f + y * (0.5f + y * (1.f / 6.f + y * (1.f / 24.f + y * (1.f / 120.f + y * (1.f / 720.f + y * (1.f / 5040.f)))))));
                const float uv = sqrtf(-em1) * ig * xcf[t * 32 + cl];
                aL[t * 33 + cl] = av; uL[t * 33 + cl] = uv; }
        __syncthreads();
        float as_[8], us_[8]; float P = 1.f, H = 0.f;
#pragma unroll
        for (int i = 0; i < 8; ++i) { as_[i] = aL[(seg * 8 + i) * 33 + dl]; us_[i] = uL[(seg * 8 + i) * 33 + dl]; H = as_[i] * H + us_[i]; P *= as_[i]; }
        sP[seg * 32 + dl] = P; sH[seg * 32 + dl] = H;
        __syncthreads();
        float h = carry[(ck & 1) * 32 + dl];
        for (int s = 0; s < seg; ++s) h = sP[s * 32 + dl] * h + sH[s * 32 + dl];
#pragma unroll
        for (int i = 0; i < 8; ++i) { h = as_[i] * h + us_[i]; const float g = bfu(gv[i]); hp[(size_t)i * 1024] = (bf16)f2bf(h * g / (1.f + __expf(-g))); }
        if (seg == 15) carry[((ck + 1) & 1) * 32 + dl] = h;
        __syncthreads();
    }
}

__device__ __forceinline__ void ln_row_inplace(float* row, const float* g, const float* bta, int lane) {
    GAS f32x4* xr = (GAS f32x4*)row + lane;
    f32x4 v[4]; float s = 0.f;
#pragma unroll
    for (int j = 0; j < 4; ++j) { v[j] = xr[64 * j]; s += (v[j].x + v[j].y) + (v[j].z + v[j].w); }
    const float mean = wave_sum(s) * (1.f / D); float s2 = 0.f;
#pragma unroll
    for (int j = 0; j < 4; ++j) { v[j] = v[j] - mean; s2 += (v[j].x * v[j].x + v[j].y * v[j].y) + (v[j].z * v[j].z + v[j].w * v[j].w); }
    const float rstd = 1.f / sqrtf(wave_sum(s2) * (1.f / D) + LN_EPS);
#pragma unroll
    for (int j = 0; j < 4; ++j) { const f32x4 gg = *((const GAS f32x4*)g + lane + 64 * j), bb = *((const GAS f32x4*)bta + lane + 64 * j); xr[64 * j] = v[j] * rstd * gg + bb; }
}

__global__ void __launch_bounds__(NWAVES * 64, 2) fwd_megakernel(Args args) {
    extern __shared__ __attribute__((aligned(16))) unsigned char lds[];
    cg::grid_group grid = cg::this_grid();
    LAS unsigned char* L = (LAS unsigned char*)lds;
    const int tid = threadIdx.x, lane = tid & 63, wave = __builtin_amdgcn_readfirstlane(tid >> 6);
    const int G = gridDim.x; const int bx = blockIdx.x; const int vcu = (G % 8 == 0) ? (bx % 8) * (G / 8) + bx / 8 : bx;
    unsigned char* ws = args.ws;
    const float* x = args.in[0];
    bf16* Win_t = (bf16*)(ws + WS_WIN); bf16* Wap_t = (bf16*)(ws + WS_WAP); bf16* Wrp_t = (bf16*)(ws + WS_WRP); bf16* Wout_t = (bf16*)(ws + WS_WOUT); float* rope = (float*)(ws + WS_ROPE);
    bf16* S0 = (bf16*)(ws + WS_S0);
    bf16* S1 = (bf16*)(ws + WS_S0 + 1 * SLOT);
    bf16* S2 = (bf16*)(ws + WS_S0 + 2 * SLOT);
    bf16* S3 = (bf16*)(ws + WS_S0 + 3 * SLOT);
    bf16* S4 = (bf16*)(ws + WS_S0 + 4 * SLOT);
    bf16* S5 = (bf16*)(ws + WS_S0 + 5 * SLOT);
    bf16* S6 = (bf16*)(ws + WS_S0 + 6 * SLOT);
    bf16* D0 = (bf16*)args.out;
    bf16* D1 = D0 + (size_t)M * D;
    float* stash = (float*)(ws + WS_STASH) + (size_t)bx * 32768;

    p0_prologue(x, args.in[1], args.in[15], args.in[16], args.in[17], Win_t, Wap_t, Wrp_t, Wout_t, D0, rope, L, vcu, G, wave, lane);
    grid.sync();
    {
        pg8::Gemm g{D0, Win_t, M, NPROJ, D, nullptr, nullptr}; pg8::StaticOrder S; S.init(M, NPROJ, G, bx);
        pg8::EpiProj E{S0, S1, S2, S3, S4, S5, S6, D1, rope, attn_body::C2, SEQ - 1};
        pg8::gemm_phase<pg8::EpiProj, pg8::StaticOrder, PG8_ALIGN, PG8_SP2>(L, g, S, E);
#ifdef PROBE_P1X2
        __syncthreads();
        pg8::gemm_phase<pg8::EpiProj, pg8::StaticOrder, PG8_ALIGN, PG8_SP2>(L, g, S, E);
#endif
    }
    grid.sync();
#ifndef NO_RNN
#ifdef PROBE_RNN2
    for (int u = vcu; u < 256; u += G)
        rnn_unit(u >> 5, (u >> 2) & 7, u & 3, S4, S5, D0, args.in[7], args.in[8], args.in[9], args.in[10], args.in[11], args.in[12], args.in[13], L);
#endif
    for (int u = vcu; u < 256; u += G)
        rnn_unit(u >> 5, (u >> 2) & 7, u & 3, S4, S5, S5, args.in[7], args.in[8], args.in[9], args.in[10], args.in[11], args.in[12], args.in[13], L);
#endif
#ifndef NO_ATT
    {
        const float l1 = wave_sum(args.in[2][lane] * args.in[3][lane]), l2 = wave_sum(args.in[4][lane] * args.in[5][lane]);
        const float lam = __builtin_bit_cast(float, __builtin_amdgcn_readfirstlane(__builtin_bit_cast(int, __expf(l1) - __expf(l2) + 0.2f)));
        for (int u = vcu; u < 1024; u += G) {
            const int w = u & 255, i = u >> 8, bh = w >> 2, s = w & 3;
            const int qb = (i == 0) ? s : (i == 1) ? 7 - s : (i == 2) ? 8 + s : 15 - s;
#ifdef ATTN_4PASS
            for (int p = 0; p < 4; ++p)
                attn_body::attn_unit<8>(bh >> 3, bh & 7, qb, p, lam, (const attn_body::bf16*)S0, (const attn_body::bf16*)S1, (const attn_body::bf16*)S2, (attn_body::bf16*)S3, args.in[6], stash, (char*)lds);
#else
            for (int p = 0; p < 2; ++p)
                attn_body::ATTN_UNIT(bh >> 3, bh & 7, qb, p, lam, (const attn_body::bf16*)S0, (const attn_body::bf16*)S1, (const attn_body::bf16*)S2, (attn_body::bf16*)S3, args.in[6], stash, (char*)lds);
#endif
        }
    }
#endif
    grid.sync();
    {
        pg8::Gemm g{S3, Wap_t, M, D, D, S5, Wrp_t}; pg8::DualOrder S; S.init(M, D, G, bx);
        pg8::EpiMerge E{S6, D1, args.in[14], S0};
        pg8::gemm_phase<pg8::EpiMerge, pg8::DualOrder, PG8_ALIGN, PG8_SP2>(L, g, S, E);
    }
    grid.sync();
    {
        pg8::Gemm g{S0, Wout_t, M, D, D, nullptr, nullptr}; pg8::StaticOrder S; S.init(M, D, G, bx);
        pg8::EpiResF32 E{x, args.out, 1.189207115002721f};
        pg8::gemm_phase<pg8::EpiResF32, pg8::StaticOrder, PG8_ALIGN, PG8_SP2>(L, g, S, E);
    }
    grid.sync();
    { int t4 = threadIdx.x; asm volatile("" : "+v"(t4)); const int lane4 = t4 & 63, wave4 = __builtin_amdgcn_readfirstlane(t4 >> 6);
    for (int m = vcu * NWAVES + wave4; m < M; m += G * NWAVES) ln_row_inplace(args.out + (size_t)m * D, args.in[18], args.in[19], lane4); }
}

extern "C" void kernel_launch(void* const* d_in, const int* in_sizes, int n_in, void* d_out, int out_size, void* d_ws, size_t ws_size, hipStream_t stream) {
    static int grid = 0;
    if (grid == 0) {
        if (n_in != 20 || in_sizes[0] != M * D || out_size != M * D || ws_size < WS_END) { fprintf(stderr, "kernel_launch: unexpected shapes (n_in %d, in0 %d, out %d, ws %zu); nothing launched\n", n_in, n_in > 0 ? in_sizes[0] : -1, out_size, ws_size); grid = -1; return; }
        int dev = 0, cus = 0, per_cu = 0;
        if (hipGetDevice(&dev) != hipSuccess || hipDeviceGetAttribute(&cus, hipDeviceAttributeMultiprocessorCount, dev) != hipSuccess) { grid = -1; return; }
        if (hipFuncSetAttribute((const void*)fwd_megakernel, hipFuncAttributeMaxDynamicSharedMemorySize, LDS_BYTES) != hipSuccess) { fprintf(stderr, "kernel_launch: hipFuncSetAttribute failed\n"); grid = -1; return; }
        if (hipOccupancyMaxActiveBlocksPerMultiprocessor(&per_cu, (const void*)fwd_megakernel, NWAVES * 64, LDS_BYTES) != hipSuccess || per_cu < 1) { fprintf(stderr, "kernel_launch: occupancy query says %d\n", per_cu); per_cu = 1; }
        (void)hipGetLastError();
        grid = cus;
    }
    if (grid < 0) return;
    Args a{};
    for (int i = 0; i < 20; ++i) a.in[i] = (const float*)d_in[i];
    a.out = (float*)d_out; a.ws = (unsigned char*)d_ws;
    void* kargs[] = {&a};
    const hipError_t e = hipLaunchCooperativeKernel((const void*)fwd_megakernel, dim3(grid), dim3(NWAVES * 64), kargs, LDS_BYTES, stream);
    if (e != hipSuccess) fprintf(stderr, "kernel_launch: cooperative launch failed: %s (grid %d)\n", hipGetErrorString(e), grid);
}
```

```cpp
#include <hip/hip_runtime.h>
#include <cstdio>
#include <cstdint>
namespace pg8 {
#define PG8_LAS __attribute__((address_space(3)))
typedef unsigned short bf16_t;
typedef short bf16x8 __attribute__((ext_vector_type(8)));
typedef float f32x4 __attribute__((ext_vector_type(4)));
typedef unsigned u32x4 __attribute__((ext_vector_type(4)));
constexpr int BM = 256, BK = 64, HALF = 128, HTB = HALF * BK * 2  , STAGE_BYTES = 8 * HTB, NXCD = 8, WGM = 8;

__host__ __device__ __forceinline__ int lds_byte(int r, int c) { const int st = (r >> 4) * 2 + (c >> 5), rr = r & 15, cc = c & 31, ob = rr * 64 + cc * 2; return st * 1024 + (ob ^ (((ob >> 9) & 1) << 5)); }
__host__ __device__ __forceinline__ void stage_rc(int b, int& R, int& C) { const int st = b / 1024, sb = b % 1024, swz = sb ^ (((sb >> 9) & 1) << 5); R = (st >> 1) * 16 + swz / 64; C = (st & 1) * 32 + (swz % 64) / 2; }
__host__ __device__ __forceinline__ int perm32(int rho) { const int n = rho >> 4, i = rho & 15; return 8 * (i >> 2) + 4 * n + (i & 3); }

struct Unit { int pm, pn, seg; };
struct Gemm { const bf16_t* A; const bf16_t* Bt; int M, N, K; const bf16_t* A2; const bf16_t* Bt2; };

struct StaticOrder {
    int nM, nN, nwg, G, c;
    __host__ __device__ void init(int M, int N, int G_, int c_) { nM = M / BM; nN = N / BM; nwg = nM * nN; G = G_; c = c_; }
    __host__ __device__ bool next(int i, Unit& u) const {
        const long L = (long)i * G + c; if (L >= nwg) return false;
        int wgid = (int)L; { const int q = nwg / NXCD, r = nwg % NXCD, xcd = wgid % NXCD, off = wgid / NXCD; wgid = (xcd < r ? xcd * (q + 1) : r * (q + 1) + (xcd - r) * q) + off; }
        const int nig = WGM * nN, gid = wgid / nig, fm = gid * WGM, gsz = (nM - fm) < WGM ? (nM - fm) : WGM;
        u.pm = fm + ((wgid % nig) % gsz); u.pn = (wgid % nig) / gsz; u.seg = 0; return true;
    }
    __device__ __forceinline__ void a_ready(const Unit&) const {}
    __device__ __forceinline__ void done(const Unit&) const {}
};

__device__ __forceinline__ unsigned cvt_pk_bf16(float lo, float hi) { unsigned r; asm volatile("v_cvt_pk_bf16_f32 %0, %1, %2" : "=v"(r) : "v"(lo), "v"(hi)); return r; }
typedef float f32x2 __attribute__((ext_vector_type(2)));
__device__ __forceinline__ f32x2 gelu_pk(f32x2 v) {
    const f32x2 av = __builtin_elementwise_abs(v), d = av * 0.2316418882f + 1.0f;
    f32x2 t; t.x = __builtin_amdgcn_rcpf(d.x); t.y = __builtin_amdgcn_rcpf(d.y);
    f32x2 q = t * 0.5307027145f + (-0.7265760135f); q = q * t + 0.7107068705f; q = q * t + (-0.142248368f); q = q * t + 0.127414796f; q = q * t;
    const f32x2 s = (v * v) * (-0.72134752044f);
    f32x2 e; e.x = __builtin_amdgcn_exp2f(s.x); e.y = __builtin_amdgcn_exp2f(s.y);
    const f32x2 m = v * (q * e), r = v - m;
    f32x2 o; o.x = v.x < 0.f ? m.x : r.x; o.y = v.y < 0.f ? m.y : r.y; return o;
}

template <int ACT  > struct EpiBf16 {
    static constexpr bool PERM = true, AFTER_DRAIN = false; static_assert(ACT == 0 || ACT == 1, "EpiBf16: ACT is 0 (none) or 1 (gelu_pk)");
    bf16_t* O; int ldc; const float* bias; int split_cols; size_t split_stride; float scale0;
    __device__ __forceinline__ void operator()(const f32x4 (&acc)[2][2][4][2], const Unit& u, int wr, int wc, int fr, int fq) const {
        const int row0 = u.pm * BM + wr * 64 + fr; int colt = u.pn * BM; bf16_t* base = O;
        float sc = 1.f; if (split_cols) { const int t = colt / split_cols; base += (size_t)t * split_stride; colt -= t * split_cols; if (t == 0) sc = scale0; }
        const int col0 = colt + wc * 32 + 8 * fq, bcol0 = u.pn * BM + wc * 32 + 8 * fq;
        f32x4 bv[2][2];
#pragma unroll
        for (int bj = 0; bj < 2; ++bj)
#pragma unroll
            for (int n = 0; n < 2; ++n) bv[bj][n] = bias ? *(const f32x4*)(bias + bcol0 + bj * HALF + 4 * n) : (f32x4){0.f, 0.f, 0.f, 0.f};
#pragma unroll
        for (int ai = 0; ai < 2; ++ai)
#pragma unroll
            for (int m = 0; m < 4; ++m) { bf16_t* rowp = base + (size_t)(row0 + ai * HALF + m * 16) * ldc + col0;
#pragma unroll
                for (int bj = 0; bj < 2; ++bj) { f32x4 v0 = acc[ai][bj][m][0] + bv[bj][0], v1 = acc[ai][bj][m][1] + bv[bj][1];
                    if (ACT == 1) { f32x2 a = gelu_pk((f32x2){v0[0], v0[1]}), b = gelu_pk((f32x2){v0[2], v0[3]}), c = gelu_pk((f32x2){v1[0], v1[1]}), d = gelu_pk((f32x2){v1[2], v1[3]});
                        v0 = (f32x4){a.x, a.y, b.x, b.y}; v1 = (f32x4){c.x, c.y, d.x, d.y}; }
                    v0 = v0 * sc; v1 = v1 * sc; u32x4 w; w.x = cvt_pk_bf16(v0[0], v0[1]); w.y = cvt_pk_bf16(v0[2], v0[3]); w.z = cvt_pk_bf16(v1[0], v1[1]); w.w = cvt_pk_bf16(v1[2], v1[3]);
                    *(u32x4*)(rowp + bj * HALF) = w; } }
    }
};

__device__ __forceinline__ float bf_lo(unsigned w) { return __builtin_bit_cast(float, w << 16); }
__device__ __forceinline__ float bf_hi(unsigned w) { return __builtin_bit_cast(float, w & 0xffff0000u); }
struct EpiProj {
    static constexpr bool PERM = true, AFTER_DRAIN = false;
    bf16_t *d0, *d1, *d2, *d3, *d4, *d5, *d6, *d7; const float* rope; float qscale; int seqmask;
    __device__ __forceinline__ void operator()(f32x4 (&acc)[2][2][4][2], const Unit& u, int wr, int wc, int fr, int fq) const {
        const int grp = u.pn >> 2;
        bf16_t* base = grp == 0 ? d0 : grp == 1 ? d1 : grp == 2 ? d2 : grp == 3 ? d3 : grp == 4 ? d4 : grp == 5 ? d5 : grp == 6 ? d6 : d7;
        const int row0 = u.pm * BM + wr * 64 + fr, col0 = (u.pn & 3) * BM + wc * 32 + 8 * fq;
        const bool rot = (grp < 2) && ((wc & 1) == 0);
        const float sc = (grp == 0) ? qscale : 1.f;
#pragma unroll
        for (int ai = 0; ai < 2; ++ai)
#pragma unroll
            for (int m = 0; m < 4; ++m) {
                const int row = row0 + ai * HALF + m * 16;
                f32x4 cs0 = {1.f, 1.f, 1.f, 1.f}, cs1 = cs0, sn0 = {0.f, 0.f, 0.f, 0.f}, sn1 = sn0;
                if (rot) { const float* rp = rope + (size_t)(row & seqmask) * 16; cs0 = *(const f32x4*)(rp); cs1 = *(const f32x4*)(rp + 4); sn0 = *(const f32x4*)(rp + 8); sn1 = *(const f32x4*)(rp + 12);
                    if (fq == 0) { sn0 = -sn0; sn1 = -sn1; } if (fq >= 2) { sn0 = (f32x4){0.f, 0.f, 0.f, 0.f}; sn1 = sn0; cs0 = (f32x4){1.f, 1.f, 1.f, 1.f}; cs1 = cs0; } }
                bf16_t* rowp = base + (size_t)row * 1024 + col0;
#pragma unroll
                for (int bj = 0; bj < 2; ++bj) {
                    f32x4 v0 = acc[ai][bj][m][0], v1 = acc[ai][bj][m][1];
                    if (rot) { f32x4 p0, p1;
#pragma unroll
                        for (int e = 0; e < 4; ++e) { p0[e] = __shfl_xor(v0[e], 16); p1[e] = __shfl_xor(v1[e], 16); }
                        v0 = v0 * cs0 + p0 * sn0; v1 = v1 * cs1 + p1 * sn1; }
                    v0 = v0 * sc; v1 = v1 * sc;
                    u32x4 w; w.x = cvt_pk_bf16(v0[0], v0[1]); w.y = cvt_pk_bf16(v0[2], v0[3]); w.z = cvt_pk_bf16(v1[0], v1[1]); w.w = cvt_pk_bf16(v1[2], v1[3]);
                    *(u32x4*)(rowp + bj * HALF) = w; }
            }
    }
};
struct EpiMerge {
    static constexpr bool PERM = true, AFTER_DRAIN = false;
    const bf16_t* matt; const bf16_t* mrnn; const float* mb; bf16_t* O;
    __device__ __forceinline__ void operator()(f32x4 (&acc)[2][2][4][2], const Unit& u, int wr, int wc, int fr, int fq) const {
        const int row0 = u.pm * BM + wr * 64 + fr, col0 = u.pn * BM + wc * 32 + 8 * fq;
#pragma unroll
        for (int bj = 0; bj < 2; ++bj) {
            const int col = col0 + bj * HALF;
            const f32x4 br0 = *(const f32x4*)(mb + 1024 + col), br1 = *(const f32x4*)(mb + 1024 + col + 4);
            const f32x4 ba0 = *(const f32x4*)(mb + col), ba1 = *(const f32x4*)(mb + col + 4);
#pragma unroll
            for (int ai = 0; ai < 2; ++ai)
#pragma unroll
                for (int m = 0; m < 4; ++m) {
                    const size_t off = (size_t)(row0 + ai * HALF + m * 16) * 1024 + col;
                    const u32x4 wr_ = *(const u32x4*)(mrnn + off);
                    float er[8];
                    er[0] = __expf(-(bf_lo(wr_.x) + br0[0])); er[1] = __expf(-(bf_hi(wr_.x) + br0[1])); er[2] = __expf(-(bf_lo(wr_.y) + br0[2])); er[3] = __expf(-(bf_hi(wr_.y) + br0[3]));
                    er[4] = __expf(-(bf_lo(wr_.z) + br1[0])); er[5] = __expf(-(bf_hi(wr_.z) + br1[1])); er[6] = __expf(-(bf_lo(wr_.w) + br1[2])); er[7] = __expf(-(bf_hi(wr_.w) + br1[3]));
                    f32x4 v0 = acc[ai][bj][m][0], v1 = acc[ai][bj][m][1];
                    if (u.seg == 0) {
                        const u32x4 wa_ = *(const u32x4*)(matt + off);
                        float ea[8];
                        ea[0] = __expf(-(bf_lo(wa_.x) + ba0[0])); ea[1] = __expf(-(bf_hi(wa_.x) + ba0[1])); ea[2] = __expf(-(bf_lo(wa_.y) + ba0[2])); ea[3] = __expf(-(bf_hi(wa_.y) + ba0[3]));
                        ea[4] = __expf(-(bf_lo(wa_.z) + ba1[0])); ea[5] = __expf(-(bf_hi(wa_.z) + ba1[1])); ea[6] = __expf(-(bf_lo(wa_.w) + ba1[2])); ea[7] = __expf(-(bf_hi(wa_.w) + ba1[3]));
#pragma unroll
                        for (int e = 0; e < 4; ++e) { v0[e] *= (1.f + er[e]) / (1.f + ea[e]); v1[e] *= (1.f + er[4 + e]) / (1.f + ea[4 + e]); }
                        acc[ai][bj][m][0] = v0; acc[ai][bj][m][1] = v1;
                    } else {
#pragma unroll
                        for (int e = 0; e < 4; ++e) { v0[e] = v0[e] / (1.f + er[e]); v1[e] = v1[e] / (1.f + er[4 + e]); }
                        u32x4 w; w.x = cvt_pk_bf16(v0[0], v0[1]); w.y = cvt_pk_bf16(v0[2], v0[3]); w.z = cvt_pk_bf16(v1[0], v1[1]); w.w = cvt_pk_bf16(v1[2], v1[3]);
                        *(u32x4*)(O + off) = w;
                    }
                }
        }
    }
};
struct EpiResF32 {
    static constexpr bool PERM = false, AFTER_DRAIN = false;
    const float* x; float* out; float alpha;
    __device__ __forceinline__ void operator()(f32x4 (&acc)[2][2][4][2], const Unit& u, int wr, int wc, int fr, int fq) const {
        const int col0 = u.pn * BM + wc * 32 + 4 * fq;
#pragma unroll
        for (int ai = 0; ai < 2; ++ai)
#pragma unroll
            for (int m = 0; m < 4; ++m) { const size_t off = (size_t)(u.pm * BM + ai * HALF + wr * 64 + m * 16 + fr) * 1024 + col0;
#pragma unroll
                for (int bj = 0; bj < 2; ++bj)
#pragma unroll
                    for (int n = 0; n < 2; ++n) { const f32x4 xv = *(const f32x4*)(x + off + bj * HALF + n * 16); *(f32x4*)(out + off + bj * HALF + n * 16) = xv * alpha + acc[ai][bj][m][n]; } }
    }
};
struct DualOrder {
    StaticOrder so;
    __host__ __device__ void init(int M, int N, int G_, int c_) { so.init(M, N, G_, c_); }
    __host__ __device__ bool next(int i, Unit& u) const { if (!so.next(i >> 1, u)) return false; u.seg = i & 1; return true; }
    __device__ __forceinline__ void a_ready(const Unit&) const {}
    __device__ __forceinline__ void done(const Unit&) const {}
};


template <class Epi, class Sched, bool ALIGN_EPI = false, bool SP2 = false>
__device__ __forceinline__ void gemm_phase(PG8_LAS unsigned char* lds, const Gemm g, const Sched& S, const Epi& E) {
    int tid = threadIdx.x; asm volatile("" : "+v"(tid));
    const int wid = __builtin_amdgcn_readfirstlane(tid >> 6), lane = tid & 63, wr = wid >> 2, wc = wid & 3, fr = lane & 15, fq = lane >> 4;
    const int K = g.K, nt = K / BK;
    unsigned voffA[2], voffB[2];
#pragma unroll
    for (int i = 0; i < 2; ++i) { int R, C; stage_rc(tid * 16 + i * 8192, R, C); const int Rb = Epi::PERM ? ((R & ~31) + perm32(R & 31)) : R;
        voffA[i] = (unsigned)(R * K + C) * 2u; voffB[i] = (unsigned)(Rb * K + C) * 2u; }
    const size_t kstep = (size_t)(BK * 2);
    const size_t hstep = (size_t)HALF * K * 2;
    const size_t tstep = 2 * hstep;
    const unsigned ldsw = (unsigned)wid * 1024u;
    const int aoff = lds_byte(wr * 64 + fr, fq * 8), boff = lds_byte(wc * 32 + fr, fq * 8);
#define PG8_SA(b, h) (((b) * 2 + (h)) * HTB)
#define PG8_SB(b, h) ((4 + (b) * 2 + (h)) * HTB)
#define PG8_STAGE(bufoff, gbase, voff) do { _Pragma("unroll") for (int _i = 0; _i < 2; ++_i) \
        __builtin_amdgcn_global_load_lds((const unsigned*)((const char*)(gbase) + (voff)[_i]), (PG8_LAS unsigned*)(lds + (bufoff) + ldsw + _i * 8192), 16, 0, 0); } while (0)
#define PG8_LDA(dst, b, h) do { _Pragma("unroll") for (int m = 0; m < 4; ++m) _Pragma("unroll") for (int k = 0; k < 2; ++k) dst[m][k] = *(const PG8_LAS bf16x8*)(lds + PG8_SA(b, h) + aoff + m * 2048 + k * 1024); } while (0)
#define PG8_LDB(dst, b, h) do { _Pragma("unroll") for (int n = 0; n < 2; ++n) _Pragma("unroll") for (int k = 0; k < 2; ++k) dst[n][k] = *(const PG8_LAS bf16x8*)(lds + PG8_SB(b, h) + boff + n * 2048 + k * 1024); } while (0)
#define PG8_MMA(ai, bj, At, Bt) do { __builtin_amdgcn_s_setprio(1); _Pragma("unroll") for (int m = 0; m < 4; ++m) _Pragma("unroll") for (int n = 0; n < 2; ++n) _Pragma("unroll") for (int k = 0; k < 2; ++k) \
        acc[ai][bj][m][n] = __builtin_amdgcn_mfma_f32_16x16x32_bf16(Bt[n][k], At[m][k], acc[ai][bj][m][n], 0, 0, 0); __builtin_amdgcn_s_setprio(0); } while (0)
#define PG8_WAIT_V(n) asm volatile("s_waitcnt vmcnt(" #n ")" ::: "memory")
#define PG8_WAIT_L(n) asm volatile("s_waitcnt lgkmcnt(" #n ")" ::: "memory")
#define PG8_BAR __builtin_amdgcn_s_barrier()
#define PG8_SCHED __builtin_amdgcn_sched_barrier(0)
    Unit cur, nxt; int ui = 0;
    if (!S.next(0, cur)) return;
    f32x4 acc[2][2][4][2];
#pragma unroll
    for (int a = 0; a < 2; ++a)
#pragma unroll
        for (int b = 0; b < 2; ++b)
#pragma unroll
            for (int m = 0; m < 4; ++m)
#pragma unroll
                for (int n = 0; n < 2; ++n) acc[a][b][m][n] = (f32x4){0.f, 0.f, 0.f, 0.f};
    bf16x8 At[4][2], B0[2][2], B1[2][2];
    const char* cA = (const char*)(cur.seg ? g.A2 : g.A) + (size_t)cur.pm * tstep; const char* cB = (const char*)(cur.seg ? g.Bt2 : g.Bt) + (size_t)cur.pn * tstep;
    S.a_ready(cur);
    if constexpr (SP2) {
        PG8_STAGE(PG8_SB(0, 0), cB, voffB); PG8_STAGE(PG8_SB(0, 1), cB + hstep, voffB); PG8_STAGE(PG8_SA(0, 0), cA, voffA); PG8_STAGE(PG8_SA(0, 1), cA + hstep, voffA);
        if (wr == 1) PG8_BAR;
        PG8_WAIT_V(2); PG8_BAR;
        PG8_STAGE(PG8_SB(1, 0), cB + kstep, voffB); PG8_STAGE(PG8_SA(1, 0), cA + kstep, voffA); PG8_STAGE(PG8_SB(1, 1), cB + hstep + kstep, voffB);
        PG8_WAIT_V(6); PG8_BAR;
    } else {
        PG8_STAGE(PG8_SB(0, 0), cB, voffB); PG8_STAGE(PG8_SA(0, 0), cA, voffA); PG8_STAGE(PG8_SB(0, 1), cB + hstep, voffB); PG8_STAGE(PG8_SA(0, 1), cA + hstep, voffA);
        if (wr == 1) PG8_BAR;
        PG8_WAIT_V(4); PG8_BAR;
        PG8_STAGE(PG8_SB(1, 0), cB + kstep, voffB); PG8_STAGE(PG8_SA(1, 0), cA + kstep, voffA); PG8_STAGE(PG8_SB(1, 1), cB + hstep + kstep, voffB);
        PG8_WAIT_V(6); PG8_BAR;
    }
    for (;;) {
        const bool has_next = S.next(ui + 1, nxt);
        const char* nA = has_next ? (const char*)(nxt.seg ? g.A2 : g.A) + (size_t)nxt.pm * tstep : cA; const char* nB = has_next ? (const char*)(nxt.seg ? g.Bt2 : g.Bt) + (size_t)nxt.pn * tstep : cB;
        for (int t = 0; t < nt; t += 2) {
            const bool last = (t == nt - 2);
            const char* a1 = cA + (size_t)(t + 1) * kstep;
            const char* a2 = last ? nA : cA + (size_t)(t + 2) * kstep; const char* b2 = last ? nB : cB + (size_t)(t + 2) * kstep;
            const char* a3 = a2 + kstep; const char* b3 = b2 + kstep;
            if (last && has_next) S.a_ready(nxt);
            if constexpr (SP2) {
            PG8_LDB(B0, 0, 0); PG8_LDB(B1, 0, 1); PG8_SCHED; PG8_LDA(At, 0, 0); PG8_STAGE(PG8_SA(1, 1), a1 + hstep, voffA);
            PG8_WAIT_V(8); PG8_WAIT_L(0); PG8_BAR; PG8_MMA(0, 0, At, B0); PG8_MMA(0, 1, At, B1); PG8_BAR; PG8_SCHED;
            PG8_LDA(At, 0, 1); PG8_STAGE(PG8_SB(0, 0), b2, voffB); PG8_STAGE(PG8_SB(0, 1), b2 + hstep, voffB); PG8_STAGE(PG8_SA(0, 0), a2, voffA);
            PG8_WAIT_V(8); PG8_WAIT_L(0); PG8_BAR; PG8_MMA(1, 0, At, B0); PG8_MMA(1, 1, At, B1); PG8_BAR; PG8_SCHED;
            PG8_LDB(B0, 1, 0); PG8_LDB(B1, 1, 1); PG8_SCHED; PG8_LDA(At, 1, 0); PG8_STAGE(PG8_SA(0, 1), a2 + hstep, voffA);
            PG8_WAIT_V(8); PG8_WAIT_L(0); PG8_BAR; PG8_MMA(0, 0, At, B0); PG8_MMA(0, 1, At, B1); PG8_BAR; PG8_SCHED;
            PG8_LDA(At, 1, 1); PG8_STAGE(PG8_SB(1, 0), b3, voffB); PG8_STAGE(PG8_SB(1, 1), b3 + hstep, voffB); PG8_STAGE(PG8_SA(1, 0), a3, voffA);
            PG8_WAIT_V(8); PG8_WAIT_L(0); PG8_BAR; PG8_MMA(1, 0, At, B0); PG8_MMA(1, 1, At, B1); PG8_BAR; PG8_SCHED;
            } else {
            PG8_LDB(B0, 0, 0); PG8_SCHED; PG8_LDA(At, 0, 0); PG8_STAGE(PG8_SA(1, 1), a1 + hstep, voffA);
            PG8_WAIT_L(8); PG8_BAR; PG8_WAIT_L(0); PG8_MMA(0, 0, At, B0); PG8_BAR; PG8_SCHED;
            PG8_LDB(B1, 0, 1); PG8_STAGE(PG8_SB(0, 0), b2, voffB);
            PG8_BAR; PG8_WAIT_L(0); PG8_MMA(0, 1, At, B1); PG8_BAR;
            PG8_LDA(At, 0, 1); PG8_STAGE(PG8_SA(0, 0), a2, voffA);
            PG8_BAR; PG8_WAIT_L(0); PG8_MMA(1, 0, At, B0); PG8_BAR; PG8_SCHED;
            PG8_STAGE(PG8_SB(0, 1), b2 + hstep, voffB);
            PG8_WAIT_V(6); PG8_BAR; PG8_MMA(1, 1, At, B1); PG8_BAR;
            PG8_LDB(B0, 1, 0); PG8_SCHED; PG8_LDA(At, 1, 0); PG8_STAGE(PG8_SA(0, 1), a2 + hstep, voffA);
            PG8_WAIT_L(8); PG8_BAR; PG8_WAIT_L(0); PG8_MMA(0, 0, At, B0); PG8_BAR; PG8_SCHED;
            PG8_LDB(B1, 1, 1); PG8_STAGE(PG8_SB(1, 0), b3, voffB);
            PG8_BAR; PG8_WAIT_L(0); PG8_MMA(0, 1, At, B1); PG8_BAR;
            PG8_LDA(At, 1, 1); PG8_STAGE(PG8_SA(1, 0), a3, voffA);
            PG8_BAR; PG8_WAIT_L(0); PG8_MMA(1, 0, At, B0); PG8_BAR; PG8_SCHED;
            PG8_STAGE(PG8_SB(1, 1), b3 + hstep, voffB);
            PG8_WAIT_V(6); PG8_BAR; PG8_MMA(1, 1, At, B1); PG8_BAR;
            }
        }
        if constexpr (ALIGN_EPI) { if (wr == 0) PG8_BAR; }
        if constexpr (!Epi::AFTER_DRAIN) { E(acc, cur, wr, wc, fr, fq); S.done(cur); }
        if (!has_next) break;
        if (nxt.seg == 0) {
#pragma unroll
        for (int a = 0; a < 2; ++a)
#pragma unroll
            for (int b = 0; b < 2; ++b)
#pragma unroll
                for (int m = 0; m < 4; ++m)
#pragma unroll
                    for (int n = 0; n < 2; ++n) acc[a][b][m][n] = (f32x4){0.f, 0.f, 0.f, 0.f};
        }
        cur = nxt; cA = nA; cB = nB; ++ui;
        if constexpr (ALIGN_EPI) { if (wr == 1) PG8_BAR; }
    }
    PG8_WAIT_V(0);
    if constexpr (!ALIGN_EPI) { if (wr == 0) PG8_BAR; }
    PG8_BAR;
    if constexpr (Epi::AFTER_DRAIN) { E.fused(acc, cur, wr, wc, fr, fq, lds, wid, lane); S.done(cur); }
#undef PG8_SA
#undef PG8_SB
#undef PG8_STAGE
#undef PG8_LDA
#undef PG8_LDB
#undef PG8_MMA
#undef PG8_WAIT_V
#undef PG8_WAIT_L
#undef PG8_BAR
#undef PG8_SCHED
}
}

#ifndef PG8_SP2
#define PG8_SP2 true
#endif
#ifndef PG8_ALIGN
#define PG8_ALIGN true
#endif
#include <hip/hip_bf16.h>
#include <cmath>
namespace attn_body {
using bf16=__hip_bfloat16;
using bf16x8=__attribute__((ext_vector_type(8)))short;
using s16x4=__attribute__((ext_vector_type(4)))short;
using f32x16=__attribute__((ext_vector_type(16)))float;
using u32x4=__attribute__((ext_vector_type(4)))unsigned;
constexpr int BATCH=8,NHEAD=8,SEQ=4096,D=64,DM=1024;
constexpr int NW=8,QBLK=32,QB=QBLK*NW,KVBLK=64,NQB=SEQ/QB;
constexpr int ATTN_PITCH=DM, ATTN_UNIT_ROWS=QB;
__device__ __forceinline__ int crow(int r,int hi){return (r&3)+8*(r>>2)+4*hi;}
#define SBAR() __builtin_amdgcn_sched_barrier(0)
__device__ __forceinline__ void cmask(f32x16&p0,f32x16&p1,int jb,int qrel,int hi){
  const float NEG=-INFINITY; int kb=64*jb+4*hi;
  #pragma unroll
  for(int r=0;r<16;++r){int kv=kb+(r&3)+8*(r>>2); if(kv>qrel)p0[r]=NEG; if(kv+32>qrel)p1[r]=NEG;}
}

constexpr int NSLOT=3, SLOTB=8192;
constexpr int LDS_K=0, LDS_V=NSLOT*SLOTB, LDS_WS=2*NSLOT*SLOTB, LDS_OST=LDS_WS+NW*64*4, LDS_BYTES=LDS_OST+NW*4096;
constexpr float C2=0.125f*1.4426950408889634f;
__device__ __forceinline__ void glds16(const void*gsrc,unsigned lds_dst){unsigned keep;
  asm volatile("s_mov_b32 %0, m0\n\ts_mov_b32 m0, %2\n\ts_nop 0\n\tglobal_load_lds_dwordx4 %1, off\n\ts_mov_b32 m0, %0":"=&s"(keep):"v"(gsrc),"s"(lds_dst):"memory");}
__device__ __forceinline__ float max3f(float a,float b,float c){float r;asm("v_max3_f32 %0, %1, %2, %3":"=v"(r):"v"(a),"v"(b),"v"(c));return r;}
__device__ __forceinline__ float max2f(float a,float b){float r;asm("v_max_f32_e32 %0, %1, %2":"=v"(r):"v"(a),"v"(b));return r;}
__device__ __forceinline__ float fadd_s(float a,float b){float r;asm("v_add_f32_e32 %0, %1, %2":"=v"(r):"v"(a),"v"(b));return r;}
__device__ __forceinline__ float fsub_s(float a,float b){float r;asm("v_sub_f32_e32 %0, %1, %2":"=v"(r):"v"(a),"v"(b));return r;}
typedef float f32x2_t __attribute__((ext_vector_type(2))); typedef __bf16 bf16x2_t __attribute__((ext_vector_type(2)));
__device__ __forceinline__ unsigned cvtpk_s(float lo,float hi){f32x2_t v={lo,hi};bf16x2_t b=__builtin_convertvector(v,bf16x2_t);return __builtin_bit_cast(unsigned,b);}
#define WAIT_BAR(N) asm volatile("s_waitcnt vmcnt(" #N ") lgkmcnt(0)\n\ts_barrier":::"memory")

__device__ __forceinline__ void qkt(f32x16&p0,f32x16&p1,const char*Kslot,const bf16x8*qr,const f32x16&negm,int r32,int hi){
  const char*kb=Kslot+hi*1024+r32*16;
  #pragma unroll
  for(int d0=0;d0<4;++d0){
    const bf16x8 b0=*reinterpret_cast<const bf16x8*>(kb+d0*2048);
    const bf16x8 b1=*reinterpret_cast<const bf16x8*>(kb+d0*2048+512);
    if(d0==0){p0=__builtin_amdgcn_mfma_f32_32x32x16_bf16(b0,qr[0],negm,0,0,0);p1=__builtin_amdgcn_mfma_f32_32x32x16_bf16(b1,qr[0],negm,0,0,0);}
    else{p0=__builtin_amdgcn_mfma_f32_32x32x16_bf16(b0,qr[d0],p0,0,0,0);p1=__builtin_amdgcn_mfma_f32_32x32x16_bf16(b1,qr[d0],p1,0,0,0);}}
}
typedef __attribute__((address_space(3))) const char* lds_cptr;
typedef short v4i16_t __attribute__((ext_vector_type(4)));
__device__ __forceinline__ void kload8(bf16x8*kf,lds_cptr kp){
  kf[0]=*(const __attribute__((address_space(3))) bf16x8*)(kp);      kf[1]=*(const __attribute__((address_space(3))) bf16x8*)(kp+512);
  kf[2]=*(const __attribute__((address_space(3))) bf16x8*)(kp+2048); kf[3]=*(const __attribute__((address_space(3))) bf16x8*)(kp+2560);
  kf[4]=*(const __attribute__((address_space(3))) bf16x8*)(kp+4096); kf[5]=*(const __attribute__((address_space(3))) bf16x8*)(kp+4608);
  kf[6]=*(const __attribute__((address_space(3))) bf16x8*)(kp+6144); kf[7]=*(const __attribute__((address_space(3))) bf16x8*)(kp+6656);
}
__device__ __forceinline__ void kload2(bf16x8*kf,lds_cptr kp,int j){ kf[2*j]=*(const __attribute__((address_space(3))) bf16x8*)(kp+j*2048); kf[2*j+1]=*(const __attribute__((address_space(3))) bf16x8*)(kp+j*2048+512); }
__device__ __forceinline__ s16x4 vtr(lds_cptr p){ return __builtin_bit_cast(s16x4,__builtin_amdgcn_ds_read_tr16_b64_v4i16((__attribute__((address_space(3))) v4i16_t*)p)); }
__device__ __forceinline__ float rowmax(const f32x16&p0,const f32x16&p1){
  float a=max3f(p0[0],p0[1],p1[0]),b=max3f(p0[2],p0[3],p1[1]);a=max3f(a,p1[2],p1[3]);
  #pragma unroll
  for(int r=4;r<16;r+=4){a=max3f(a,p0[r],p0[r+1]);b=max3f(b,p0[r+2],p0[r+3]);a=max3f(a,p1[r],p1[r+1]);b=max3f(b,p1[r+2],p1[r+3]);}
  const float m=max2f(a,b);
  auto rr=__builtin_amdgcn_permlane32_swap(__float_as_uint(m),__float_as_uint(m),false,false);
  return max2f(__uint_as_float(rr[0]),__uint_as_float(rr[1]));
}
__device__ __forceinline__ void pv(f32x16*o,int vb,bf16x8 pa0,bf16x8 pa1,bf16x8 pa2,bf16x8 pa3){
  #pragma unroll
  for(int d0=0;d0<2;++d0){s16x4 lo[4],hi[4];
    #pragma unroll
    for(int ks=0;ks<4;++ks){
      asm volatile("ds_read_b64_tr_b16 %0,%1 offset:%c2":"=&v"(lo[ks]):"v"(vb),"i"(d0*4096+ks*1024):"memory");
      asm volatile("ds_read_b64_tr_b16 %0,%1 offset:%c2":"=&v"(hi[ks]):"v"(vb),"i"(d0*4096+ks*1024+512):"memory");}
    asm volatile("s_waitcnt lgkmcnt(0)":::"memory");SBAR();
    #define PK(k) (bf16x8){lo[k][0],lo[k][1],lo[k][2],lo[k][3],hi[k][0],hi[k][1],hi[k][2],hi[k][3]}
    o[d0]=__builtin_amdgcn_mfma_f32_32x32x16_bf16(pa0,PK(0),o[d0],0,0,0);
    o[d0]=__builtin_amdgcn_mfma_f32_32x32x16_bf16(pa1,PK(1),o[d0],0,0,0);
    o[d0]=__builtin_amdgcn_mfma_f32_32x32x16_bf16(pa2,PK(2),o[d0],0,0,0);
    o[d0]=__builtin_amdgcn_mfma_f32_32x32x16_bf16(pa3,PK(3),o[d0],0,0,0);
    #undef PK
  }
}

#ifndef ATTN_STORE16
#define ATTN_STORE16(p,v) (*(u32x4*)(p)=(v))
#endif
template<int THRL> __device__ __forceinline__ void attn_unit(int b,int h,int qb,int p,float lam,const bf16*Q,const bf16*__restrict__ K,const bf16*__restrict__ V,bf16*GO,const float*__restrict__ subg,float*stash,char*shm){
  int tid=threadIdx.x; asm volatile("":"+v"(tid)); const int lane=tid&63,r32=lane&31,hi=lane>>5; const int wid=__builtin_amdgcn_readfirstlane(tid>>6);
  const long rowbase=(long)b*SEQ; const int q0=qb*QB;
  const int qkcol=h*128+(p&1)*64, vcol=h*128+(p>>1)*64;
  const bf16*Qw=Q+(rowbase+q0+wid*QBLK)*DM+qkcol;
  const bf16*Kh=K+rowbase*DM+qkcol,*Vh=V+rowbase*DM+vcol;
  const unsigned lds0=(unsigned)(uintptr_t)shm;
  float*wsf=(float*)(shm+LDS_WS)+wid*64;
  const bf16*ksrc=Kh+(long)lane*DM+wid*8;
  const bf16*vsrc=Vh+(long)(16*(wid&3)+(lane>>2))*DM+(wid>>2)*32+(lane&3)*8;
  const unsigned kdst=lds0+LDS_K+wid*1024, vdst=lds0+LDS_V+wid*1024;
  #define DMA_K(t,slot) glds16(ksrc+(long)(t)*KVBLK*DM,(unsigned)__builtin_amdgcn_readfirstlane(kdst+(slot)))
  #define DMA_V(t,slot) glds16(vsrc+(long)(t)*KVBLK*DM,(unsigned)__builtin_amdgcn_readfirstlane(vdst+(slot)))
  const int vb0=(int)(lds0+LDS_V)+((lane>>4)&1)*32+(lane&3)*8+(4*hi+((lane&15)>>2))*64;
  const char*Kbase=shm+LDS_K; bf16x8 kf[8];
  const lds_cptr shm3=(lds_cptr)shm; const lds_cptr kp0=shm3+LDS_K+hi*1024+r32*16; const lds_cptr vp0=shm3+LDS_V+((lane>>4)&1)*32+(lane&3)*8+(4*hi+((lane&15)>>2))*64;
  const int NT=(q0+QB)/KVBLK;
  DMA_K(0,0);DMA_V(0,0);DMA_K(1,SLOTB);
  bf16x8 qr[4];
  #pragma unroll
  for(int d0=0;d0<4;++d0)qr[d0]=*reinterpret_cast<const bf16x8*>(&Qw[(long)r32*DM+d0*16+hi*8]);
  float mhat=0.f,l_reg=0.f;f32x16 o[2];o[0]=f32x16{};o[1]=f32x16{};f32x16 negm=f32x16{};asm volatile("":"+v"(negm));
  const int qrel=wid*QBLK+r32;
  #define CMASK(P0,P1,t) do{int jb_=(t)-(NT-4); if(jb_>=0)cmask(P0,P1,jb_,qrel,hi);}while(0)
  bool resc=false;
  #define START(P0,P1) do{ const float rm=rowmax(P0,P1); resc=false; \
    { const float dl=rm; mhat=fadd_s(mhat,dl); \
      _Pragma("unroll") for(int r=0;r<16;++r){P0[r]=fsub_s(P0[r],dl);P1[r]=fsub_s(P1[r],dl);} \
      _Pragma("unroll") for(int r=0;r<16;++r)negm[r]=-mhat; asm volatile("":"+v"(negm)); } \
    _Pragma("unroll") for(int r=0;r<16;++r)P0[r]=__builtin_amdgcn_exp2f(P0[r]); }while(0)
  #define RESC() do{ if(resc){ asm volatile("s_waitcnt lgkmcnt(0)":::"memory"); \
      _Pragma("unroll") for(int d_=0;d_<2;++d_) _Pragma("unroll") for(int r=0;r<16;++r)o[d_][r]*=wsf[crow(r,hi)]; } }while(0)
  f32x16 pA0,pA1,pB0,pB1;
  int sl_prev=0,sl_cur=0,sl_next=SLOTB;
  #define ROT() do{sl_prev=sl_cur;sl_cur=sl_next;sl_next=(sl_next==(NSLOT-1)*SLOTB)?0:sl_next+SLOTB;}while(0)
  DMA_K(2,2*SLOTB);
  WAIT_BAR(3);
  qkt(pA0,pA1,Kbase,qr,negm,r32,hi);asm volatile("s_nop 15\n\ts_nop 7":"+v"(pA0),"+v"(pA1));CMASK(pA0,pA1,0);
  START(pA0,pA1);
  _Pragma("unroll") for(int r=0;r<16;++r)pA1[r]=__builtin_amdgcn_exp2f(pA1[r]);
  WAIT_BAR(0);
  DMA_K(3,0);DMA_V(1,SLOTB);
  ROT();
  kload8(kf,kp0+sl_cur);
  WAIT_BAR(2);
  s16x4 vlo[8],vhi[8]; u32x4 pw0,pw1,pw2,pw3;
  #define PKW(P,B) cvtpk_s(P[B],P[B+1])
  #define PAF(k) __builtin_bit_cast(bf16x8,pw##k)
  #define VFR(i) (bf16x8){vlo[i][0],vlo[i][1],vlo[i][2],vlo[i][3],vhi[i][0],vhi[i][1],vhi[i][2],vhi[i][3]}
  #define PIN(x) asm volatile("":"+v"(x))
  #define MX3(a,b,c) __builtin_fmaxf(__builtin_fmaxf((a),(b)),(c))
  #define GAPA(MF,A0,A1,A2,A3,W0,W1,PW) do{ MF; sacc+=A0; sacc+=A1; sacc+=A2; sacc+=A3; PIN(sacc); W0; W1; PIN(PW); SBAR(); }while(0)
  #define EX(v) __builtin_amdgcn_exp2f(v)
  #define GAPB(MF,X,B) do{ MF; X[B]=EX(X[B]); X[B+1]=EX(X[B+1]); X[B+2]=EX(X[B+2]); X[B+3]=EX(X[B+3]); PIN(X); SBAR(); }while(0)
  #define VRD(i) do{ vlo[i]=vtr(vp_+(((i)>>2)*4096+((i)&3)*1024)); vhi[i]=vtr(vp_+(((i)>>2)*4096+((i)&3)*1024+512)); }while(0)
  #define KRD(G,j) do{ if(G){ kload2(kf,kp0+sl_next,j); SBAR(); } }while(0)
  #define STEP(C0,C1,P0,P1,t,GK,GV,GL) do{ SBAR(); \
    const lds_cptr vp_=vp0+sl_prev; \
    VRD(0); SBAR(); float sacc=(P0[0]+P0[1]); \
    GAPA(C0=__builtin_amdgcn_mfma_f32_32x32x16_bf16(kf[0],qr[0],negm,0,0,0), P0[2],P0[3],P0[4],P0[5],     pw0[0]=PKW(P0,0), pw0[1]=PKW(P0,2), pw0); \
    VRD(4); SBAR(); GAPA(C1=__builtin_amdgcn_mfma_f32_32x32x16_bf16(kf[1],qr[0],negm,0,0,0), P0[6],P0[7],P0[8],P0[9],     pw0[2]=PKW(P0,4), pw0[3]=PKW(P0,6), pw0); \
    VRD(1); SBAR(); GAPA(C0=__builtin_amdgcn_mfma_f32_32x32x16_bf16(kf[2],qr[1],C0,0,0,0),   P0[10],P0[11],P0[12],P0[13], pw1[0]=PKW(P0,8), pw1[1]=PKW(P0,10), pw1); \
    VRD(5); SBAR(); GAPA(C1=__builtin_amdgcn_mfma_f32_32x32x16_bf16(kf[3],qr[1],C1,0,0,0),   P0[14],P0[15],P1[0],P1[1],   pw1[2]=PKW(P0,12),pw1[3]=PKW(P0,14), pw1); \
    VRD(2); SBAR(); GAPA(C0=__builtin_amdgcn_mfma_f32_32x32x16_bf16(kf[4],qr[2],C0,0,0,0),   P1[2],P1[3],P1[4],P1[5],     pw2[0]=PKW(P1,0), pw2[1]=PKW(P1,2), pw2); \
    VRD(6); SBAR(); GAPA(C1=__builtin_amdgcn_mfma_f32_32x32x16_bf16(kf[5],qr[2],C1,0,0,0),   P1[6],P1[7],P1[8],P1[9],     pw2[2]=PKW(P1,4), pw2[3]=PKW(P1,6), pw2); \
    VRD(3); SBAR(); GAPA(C0=__builtin_amdgcn_mfma_f32_32x32x16_bf16(kf[6],qr[3],C0,0,0,0),   P1[10],P1[11],P1[12],P1[13], pw3[0]=PKW(P1,8), pw3[1]=PKW(P1,10), pw3); \
    VRD(7); SBAR(); GAPA(C1=__builtin_amdgcn_mfma_f32_32x32x16_bf16(kf[7],qr[3],C1,0,0,0),   P1[14],P1[15],0.f,0.f,       pw3[2]=PKW(P1,12),pw3[3]=PKW(P1,14), pw3); \
    l_reg+=sacc; \
    if(GK){DMA_K((t)+3,sl_cur);} if(GV){DMA_V((t)+1,sl_next);} \
    CMASK(C0,C1,t); \
    { float a=MX3(C0[0],C0[1],C1[0]),b=MX3(C0[2],C0[3],C1[1]); a=MX3(a,C1[2],C1[3]); \
      _Pragma("unroll") for(int r=4;r<16;r+=4){a=MX3(a,C0[r],C0[r+1]);b=MX3(b,C0[r+2],C0[r+3]);a=MX3(a,C1[r],C1[r+1]);b=MX3(b,C1[r+2],C1[r+3]);} \
      float rm=__builtin_fmaxf(a,b); { auto rr=__builtin_amdgcn_permlane32_swap(__float_as_uint(rm),__float_as_uint(rm),false,false); rm=__builtin_fmaxf(__uint_as_float(rr[0]),__uint_as_float(rr[1])); } \
      resc=false; \
      if(__builtin_expect(__any(rm>(float)THRL),0)){ const float dl=__builtin_fmaxf(rm,0.f); mhat+=dl; \
        _Pragma("unroll") for(int r=0;r<16;++r){C0[r]-=dl;C1[r]-=dl;} \
        _Pragma("unroll") for(int r=0;r<16;++r)negm[r]=-mhat; asm volatile("":"+v"(negm)); \
        const float f=__builtin_amdgcn_exp2f(-dl); l_reg*=f; if(hi==0)wsf[r32]=f; resc=true; } } \
    SBAR(); \
    GAPB(o[0]=__builtin_amdgcn_mfma_f32_32x32x16_bf16(PAF(0),VFR(0),o[0],0,0,0), C0,0); \
    GAPB(o[1]=__builtin_amdgcn_mfma_f32_32x32x16_bf16(PAF(0),VFR(4),o[1],0,0,0), C0,4); \
    KRD(GL,0); GAPB(o[0]=__builtin_amdgcn_mfma_f32_32x32x16_bf16(PAF(1),VFR(1),o[0],0,0,0), C0,8); \
    KRD(GL,1); GAPB(o[1]=__builtin_amdgcn_mfma_f32_32x32x16_bf16(PAF(1),VFR(5),o[1],0,0,0), C0,12); \
    KRD(GL,2); GAPB(o[0]=__builtin_amdgcn_mfma_f32_32x32x16_bf16(PAF(2),VFR(2),o[0],0,0,0), C1,0); \
    KRD(GL,3); GAPB(o[1]=__builtin_amdgcn_mfma_f32_32x32x16_bf16(PAF(2),VFR(6),o[1],0,0,0), C1,4); \
    GAPB(o[0]=__builtin_amdgcn_mfma_f32_32x32x16_bf16(PAF(3),VFR(3),o[0],0,0,0), C1,8); \
    GAPB(o[1]=__builtin_amdgcn_mfma_f32_32x32x16_bf16(PAF(3),VFR(7),o[1],0,0,0), C1,12); \
    }while(0)
  int t=1;
  #undef CMASK
  #define CMASK(P0,P1,t) do{}while(0)
  for(;t+5<NT;t+=2){
    STEP(pB0,pB1,pA0,pA1,t,true,true,true);     WAIT_BAR(2); RESC(); ROT();
    STEP(pA0,pA1,pB0,pB1,t+1,true,true,true);   WAIT_BAR(2); RESC(); ROT();
  }
  #undef CMASK
  #define CMASK(P0,P1,t) do{int jb_=(t)-(NT-4); if(jb_>=0)cmask(P0,P1,jb_,qrel,hi);}while(0)
  #define ENDW(tt) do{ if((tt)+3<NT){WAIT_BAR(2);} else if((tt)+2<NT){WAIT_BAR(1);} else {WAIT_BAR(0);} }while(0)
  for(;t+1<NT;t+=2){
    STEP(pB0,pB1,pA0,pA1,t,(t+3<NT),(t+1<NT),(t+1<NT));       ENDW(t);   RESC(); ROT();
    STEP(pA0,pA1,pB0,pB1,t+1,(t+4<NT),(t+2<NT),(t+2<NT));     ENDW(t+1); RESC(); ROT();
  }
  STEP(pB0,pB1,pA0,pA1,NT-1,false,false,false); RESC();
  { float sacc=pB0[0]+pB0[1]; _Pragma("unroll") for(int r=2;r<16;++r)sacc+=pB0[r]; _Pragma("unroll") for(int r=0;r<16;++r)sacc+=pB1[r]; l_reg+=sacc;
    pw0=(u32x4){PKW(pB0,0),PKW(pB0,2),PKW(pB0,4),PKW(pB0,6)};pw1=(u32x4){PKW(pB0,8),PKW(pB0,10),PKW(pB0,12),PKW(pB0,14)};pw2=(u32x4){PKW(pB1,0),PKW(pB1,2),PKW(pB1,4),PKW(pB1,6)};pw3=(u32x4){PKW(pB1,8),PKW(pB1,10),PKW(pB1,12),PKW(pB1,14)};
    SBAR(); pv(o,vb0+sl_cur,PAF(0),PAF(1),PAF(2),PAF(3)); }
  #undef PKW
  #undef PAF
  #undef VFR
  #undef PIN
  #undef MX3
  #undef GAPA
  #undef GAPB
  #undef EX
  #undef VRD
  #undef KRD
  #undef STEP
  #undef ENDW
  {auto rr=__builtin_amdgcn_permlane32_swap(__float_as_uint(l_reg),__float_as_uint(l_reg),false,false);l_reg=__uint_as_float(rr[0])+__uint_as_float(rr[1]);}
  if(hi==0)wsf[32+r32]=l_reg;asm volatile("s_waitcnt lgkmcnt(0)":::"memory");
  float rli[16];
  #pragma unroll
  for(int r=0;r<16;++r)rli[r]=__builtin_amdgcn_rcpf(wsf[32+crow(r,hi)]);
  #pragma unroll
  for(int r=0;r<16;++r){o[0][r]*=rli[r];o[1][r]*=rli[r];}
  float*stA=stash+(size_t)(wid*32)*64+lane; float*stB=stash+(size_t)((8+wid)*32)*64+lane;
  if(p==0){
    #pragma unroll
    for(int k=0;k<32;++k)stA[k*64]=o[k>>4][k&15];
  }else if(p==2){
    #pragma unroll
    for(int k=0;k<32;++k)stB[k*64]=o[k>>4][k&15];
  }else if(p==1){
    #pragma unroll
    for(int k=0;k<32;++k)stA[k*64]=stA[k*64]-lam*o[k>>4][k&15];
  }else{
    f32x16 fa[2];
    #pragma unroll
    for(int k=0;k<32;++k){o[k>>4][k&15]=stB[k*64]-lam*o[k>>4][k&15]; fa[k>>4][k&15]=stA[k*64];}
    #pragma unroll
    for(int r=0;r<16;++r){
      float ss=fa[0][r]*fa[0][r]+fa[1][r]*fa[1][r]+o[0][r]*o[0][r]+o[1][r]*o[1][r];
      ss+=__shfl_xor(ss,1);ss+=__shfl_xor(ss,2);ss+=__shfl_xor(ss,4);ss+=__shfl_xor(ss,8);ss+=__shfl_xor(ss,16);
      const float rs=1.0f/sqrtf(ss*(1.0f/128.0f)+1e-5f);
      fa[0][r]*=rs;fa[1][r]*=rs;o[0][r]*=rs;o[1][r]*=rs;}
    bf16*stg=(bf16*)(shm+LDS_OST)+wid*2048;
    bf16*Gw=GO+(rowbase+q0+wid*QBLK)*DM+h*128;
    #pragma unroll
    for(int hv=0;hv<2;++hv){
      #pragma unroll
      for(int r=0;r<16;++r){const int orow=crow(r,hi);
        #pragma unroll
        for(int d0=0;d0<2;++d0)stg[orow*64+d0*32+r32]=__float2bfloat16(hv==0?fa[d0][r]:o[d0][r]);}
      asm volatile("s_waitcnt lgkmcnt(0)":::"memory");
      #pragma unroll
      for(int i=0;i<4;++i){const int row=i*8+(lane>>3),ch=lane&7; const u32x4 v=*(const u32x4*)(stg+row*64+ch*8);
        bf16*gp=Gw+(long)row*DM+hv*64+ch*8; const u32x4 gt=*(const u32x4*)gp;
        const float4 s0=*(const float4*)(subg+hv*64+ch*8), s1=*(const float4*)(subg+hv*64+ch*8+4);
        const float sg[8]={s0.x,s0.y,s0.z,s0.w,s1.x,s1.y,s1.z,s1.w}; float rr_[8];
        #pragma unroll
        for(int e=0;e<4;++e){ const unsigned vw=v[e], gw=gt[e];
          const float v0=__uint_as_float(vw<<16), v1=__uint_as_float(vw&0xffff0000u), g0=__uint_as_float(gw<<16), g1=__uint_as_float(gw&0xffff0000u);
          rr_[2*e]=v0*sg[2*e]*0.8f*g0/(1.0f+__expf(-g0)); rr_[2*e+1]=v1*sg[2*e+1]*0.8f*g1/(1.0f+__expf(-g1)); }
        u32x4 ov; ov[0]=cvtpk_s(rr_[0],rr_[1]); ov[1]=cvtpk_s(rr_[2],rr_[3]); ov[2]=cvtpk_s(rr_[4],rr_[5]); ov[3]=cvtpk_s(rr_[6],rr_[7]);
        *(u32x4*)gp=ov; }
      asm volatile("s_waitcnt lgkmcnt(0)":::"memory");
    }
  }
  asm volatile("s_waitcnt lgkmcnt(0)\n\ts_barrier":::"memory");
  #undef DMA_K
  #undef DMA_V
  #undef CMASK
  #undef START
  #undef RESC
  #undef ROT
}
constexpr int ATTN_LDS_BYTES=LDS_BYTES;
constexpr int K2_SLOT=8192, V2_SLOT=16384;
constexpr int L2_K=0, L2_V=3*K2_SLOT, L2_WS=L2_V+3*V2_SLOT, L2_OST=L2_WS+NW*64*4, LDS2_BYTES=L2_OST+NW*4096;
__device__ __forceinline__ void attn_unit2(int b,int h,int qb,int m,float lam,const bf16*Q,const bf16*__restrict__ K,const bf16*__restrict__ V,bf16*GO,const float*__restrict__ subg,float*stash,char*shm){
  int tid=threadIdx.x; asm volatile("":"+v"(tid)); const int lane=tid&63,r32=lane&31,hi=lane>>5; const int wid=__builtin_amdgcn_readfirstlane(tid>>6);
  const long rowbase=(long)b*SEQ; const int q0=qb*QB;
  const int qkcol=h*128+m*64, vcol=h*128;
  const bf16*Qw=Q+(rowbase+q0+wid*QBLK)*DM+qkcol;
  const bf16*Kh=K+rowbase*DM+qkcol,*Vh=V+rowbase*DM+vcol;
  const unsigned lds0=(unsigned)(uintptr_t)shm;
  float*wsf=(float*)(shm+L2_WS)+wid*64;
  const bf16*ksrc=Kh+(long)lane*DM+wid*8;
  const bf16*vsrc=Vh+(long)(16*(wid&3)+(lane>>2))*DM+(wid>>2)*32+(lane&3)*8;
  const unsigned kdst=lds0+L2_K+wid*1024, vdst=lds0+L2_V+wid*1024;
  #define DMA2(t,s) do{ const long go_=(long)(t)*KVBLK*DM; \
    glds16(ksrc+go_,(unsigned)__builtin_amdgcn_readfirstlane(kdst+(s)*K2_SLOT)); \
    glds16(vsrc+go_,(unsigned)__builtin_amdgcn_readfirstlane(vdst+(s)*V2_SLOT)); \
    glds16(vsrc+go_+64,(unsigned)__builtin_amdgcn_readfirstlane(vdst+(s)*V2_SLOT+8192)); }while(0)
  const int vb0=(int)(lds0+L2_V)+((lane>>4)&1)*32+(lane&3)*8+(4*hi+((lane&15)>>2))*64;
  const char*Kbase=shm+L2_K;
  const int NT=(q0+QB)/KVBLK;
  asm volatile("s_waitcnt vmcnt(0)":::"memory");
  bf16x8 qr[4];
  #pragma unroll
  for(int d0=0;d0<4;++d0)qr[d0]=*reinterpret_cast<const bf16x8*>(&Qw[(long)r32*DM+d0*16+hi*8]);
  asm volatile("":"+v"(qr[0]),"+v"(qr[1]),"+v"(qr[2]),"+v"(qr[3])::"memory");
  DMA2(0,0); DMA2(1,1);
  float mhat=0.f,l_reg=0.f; f32x16 o[4]; o[0]=f32x16{};o[1]=f32x16{};o[2]=f32x16{};o[3]=f32x16{}; f32x16 negm=f32x16{};
  const int qrel=wid*QBLK+r32;
  int slot=0;
  for(int t=0;t<NT;++t){
    if(t+1<NT){WAIT_BAR(3);}else{WAIT_BAR(0);}
    if(t+2<NT){ const int s2=(slot==0)?2:slot-1; DMA2(t+2,s2); }
    f32x16 p0,p1;
    qkt(p0,p1,Kbase+slot*K2_SLOT,qr,negm,r32,hi);
    { const int jb=t-(NT-4); if(jb>=0)cmask(p0,p1,jb,qrel,hi); }
    float rm=fmaxf(p0[0],p1[0]);
    #pragma unroll
    for(int r=1;r<16;++r){rm=fmaxf(rm,p0[r]);rm=fmaxf(rm,p1[r]);}
    { auto rr=__builtin_amdgcn_permlane32_swap(__float_as_uint(rm),__float_as_uint(rm),false,false); rm=fmaxf(__uint_as_float(rr[0]),__uint_as_float(rr[1])); }
    if(t==0){ mhat=rm;
      #pragma unroll
      for(int r=0;r<16;++r){p0[r]-=rm;p1[r]-=rm;negm[r]=-mhat;}
    }else if(__any(rm>8.0f)){ const float dl=fmaxf(rm,0.f); mhat+=dl;
      #pragma unroll
      for(int r=0;r<16;++r){p0[r]-=dl;p1[r]-=dl;negm[r]=-mhat;}
      const float f=__builtin_amdgcn_exp2f(-dl); l_reg*=f; if(hi==0)wsf[r32]=f;
      asm volatile("s_waitcnt lgkmcnt(0)":::"memory");
      #pragma unroll
      for(int r=0;r<16;++r){const float fr_=wsf[crow(r,hi)]; o[0][r]*=fr_;o[1][r]*=fr_;o[2][r]*=fr_;o[3][r]*=fr_;}
    }
    float sacc=0.f;
    #pragma unroll
    for(int r=0;r<16;++r){p0[r]=__builtin_amdgcn_exp2f(p0[r]);p1[r]=__builtin_amdgcn_exp2f(p1[r]);sacc+=p0[r]+p1[r];}
    l_reg+=sacc;
    u32x4 pw0,pw1,pw2,pw3;
    pw0=(u32x4){cvtpk_s(p0[0],p0[1]),cvtpk_s(p0[2],p0[3]),cvtpk_s(p0[4],p0[5]),cvtpk_s(p0[6],p0[7])};
    pw1=(u32x4){cvtpk_s(p0[8],p0[9]),cvtpk_s(p0[10],p0[11]),cvtpk_s(p0[12],p0[13]),cvtpk_s(p0[14],p0[15])};
    pw2=(u32x4){cvtpk_s(p1[0],p1[1]),cvtpk_s(p1[2],p1[3]),cvtpk_s(p1[4],p1[5]),cvtpk_s(p1[6],p1[7])};
    pw3=(u32x4){cvtpk_s(p1[8],p1[9]),cvtpk_s(p1[10],p1[11]),cvtpk_s(p1[12],p1[13]),cvtpk_s(p1[14],p1[15])};
    const int vb=vb0+slot*V2_SLOT;
    pv(o,vb,__builtin_bit_cast(bf16x8,pw0),__builtin_bit_cast(bf16x8,pw1),__builtin_bit_cast(bf16x8,pw2),__builtin_bit_cast(bf16x8,pw3));
    pv(o+2,vb+8192,__builtin_bit_cast(bf16x8,pw0),__builtin_bit_cast(bf16x8,pw1),__builtin_bit_cast(bf16x8,pw2),__builtin_bit_cast(bf16x8,pw3));
    slot=(slot==2)?0:slot+1;
  }
  #undef DMA2
  {auto rr=__builtin_amdgcn_permlane32_swap(__float_as_uint(l_reg),__float_as_uint(l_reg),false,false);l_reg=__uint_as_float(rr[0])+__uint_as_float(rr[1]);}
  if(hi==0)wsf[32+r32]=l_reg;asm volatile("s_waitcnt lgkmcnt(0)":::"memory");
  #pragma unroll
  for(int r=0;r<16;++r){const float rl=__builtin_amdgcn_rcpf(wsf[32+crow(r,hi)]); o[0][r]*=rl;o[1][r]*=rl;o[2][r]*=rl;o[3][r]*=rl;}
  float*st=stash+(size_t)(wid*64)*64+lane;
  if(m==0){
    #pragma unroll
    for(int k=0;k<64;++k)st[k*64]=o[k>>4][k&15];
  }else{
    #pragma unroll
    for(int k=0;k<64;++k)o[k>>4][k&15]=st[k*64]-lam*o[k>>4][k&15];
    #pragma unroll
    for(int r=0;r<16;++r){
      float ss=o[0][r]*o[0][r]+o[1][r]*o[1][r]+o[2][r]*o[2][r]+o[3][r]*o[3][r];
      ss+=__shfl_xor(ss,1);ss+=__shfl_xor(ss,2);ss+=__shfl_xor(ss,4);ss+=__shfl_xor(ss,8);ss+=__shfl_xor(ss,16);
      const float rs=1.0f/sqrtf(ss*(1.0f/128.0f)+1e-5f);
      o[0][r]*=rs;o[1][r]*=rs;o[2][r]*=rs;o[3][r]*=rs;}
    float*stg=(float*)(shm+L2_OST)+wid*1024;
    bf16*Gw=GO+(rowbase+q0+wid*QBLK)*DM+h*128;
    #pragma unroll
    for(int d0=0;d0<4;++d0){
      #pragma unroll
      for(int r=0;r<16;++r)stg[crow(r,hi)*32+r32]=o[d0][r];
      asm volatile("s_waitcnt lgkmcnt(0)":::"memory");
      #pragma unroll
      for(int i=0;i<2;++i){const int row=i*16+(lane>>2),ch=lane&3; const float4 va=*(const float4*)(stg+row*32+ch*8), vb_=*(const float4*)(stg+row*32+ch*8+4);
        bf16*gp=Gw+(long)row*DM+d0*32+ch*8; const u32x4 gt=*(const u32x4*)gp;
        const float4 s0=*(const float4*)(subg+d0*32+ch*8), s1=*(const float4*)(subg+d0*32+ch*8+4);
        const float vv[8]={va.x,va.y,va.z,va.w,vb_.x,vb_.y,vb_.z,vb_.w}; const float sg[8]={s0.x,s0.y,s0.z,s0.w,s1.x,s1.y,s1.z,s1.w}; float rr_[8];
        #pragma unroll
        for(int e=0;e<4;++e){ const unsigned gw=gt[e]; const float g0=__uint_as_float(gw<<16), g1=__uint_as_float(gw&0xffff0000u);
          rr_[2*e]=vv[2*e]*sg[2*e]*0.8f*g0/(1.0f+__expf(-g0)); rr_[2*e+1]=vv[2*e+1]*sg[2*e+1]*0.8f*g1/(1.0f+__expf(-g1)); }
        u32x4 ov; ov[0]=cvtpk_s(rr_[0],rr_[1]); ov[1]=cvtpk_s(rr_[2],rr_[3]); ov[2]=cvtpk_s(rr_[4],rr_[5]); ov[3]=cvtpk_s(rr_[6],rr_[7]);
        *(u32x4*)gp=ov; }
      asm volatile("s_waitcnt lgkmcnt(0)":::"memory");
    }
  }
  asm volatile("s_waitcnt lgkmcnt(0)\n\ts_barrier":::"memory");
}
template<int THRL> __device__ __forceinline__ void attn_unit3(int b,int h,int qb,int m,float lam,const bf16*Q,const bf16*__restrict__ K,const bf16*__restrict__ V,bf16*GO,const float*__restrict__ subg,float*stash,char*shm){
  int tid=threadIdx.x; asm volatile("":"+v"(tid)); const int lane=tid&63,r32=lane&31,hi=lane>>5; const int wid=__builtin_amdgcn_readfirstlane(tid>>6);
  const long rowbase=(long)b*SEQ; const int q0=qb*QB;
  const int qkcol=h*128+m*64, vcol=h*128;
  const bf16*Qw=Q+(rowbase+q0+wid*QBLK)*DM+qkcol;
  const bf16*Kh=K+rowbase*DM+qkcol,*Vh=V+rowbase*DM+vcol;
  const unsigned lds0=(unsigned)(uintptr_t)shm;
  float*wsf=(float*)(shm+L2_WS)+wid*64;
  const bf16*ksrc=Kh+(long)lane*DM+wid*8;
  const bf16*vsrc=Vh+(long)(16*(wid&3)+(lane>>2))*DM+(wid>>2)*32+(lane&3)*8;
  const unsigned kdst=lds0+L2_K+wid*1024, vdst=lds0+L2_V+wid*1024;
  #define DMA_K(t,slot) glds16(ksrc+(long)(t)*KVBLK*DM,(unsigned)__builtin_amdgcn_readfirstlane(kdst+(slot)))
  #define DMA_V(t,slot) do{ glds16(vsrc+(long)(t)*KVBLK*DM,(unsigned)__builtin_amdgcn_readfirstlane(vdst+2*(slot))); glds16(vsrc+(long)(t)*KVBLK*DM+64,(unsigned)__builtin_amdgcn_readfirstlane(vdst+2*(slot)+8192)); }while(0)
  const int vb0=(int)(lds0+L2_V)+((lane>>4)&1)*32+(lane&3)*8+(4*hi+((lane&15)>>2))*64;
  const char*Kbase=shm+L2_K; bf16x8 kf[8];
  const lds_cptr shm3=(lds_cptr)shm; const lds_cptr kp0=shm3+L2_K+hi*1024+r32*16; const lds_cptr vp0=shm3+L2_V+((lane>>4)&1)*32+(lane&3)*8+(4*hi+((lane&15)>>2))*64;
  const int NT=(q0+QB)/KVBLK;
  asm volatile("s_waitcnt vmcnt(0)":::"memory");
  DMA_K(0,0);DMA_V(0,0);DMA_K(1,SLOTB);
  bf16x8 qr[4];
  #pragma unroll
  for(int d0=0;d0<4;++d0)qr[d0]=*reinterpret_cast<const bf16x8*>(&Qw[(long)r32*DM+d0*16+hi*8]);
  const lds_cptr qp=shm3+L2_OST+wid*4096+lane*16;
  #define QLD(j) (*(const __attribute__((address_space(3))) bf16x8*)(qp+(j)*1024))
  float mhat=0.f,l_reg=0.f;f32x16 o[4];o[0]=f32x16{};o[1]=f32x16{};o[2]=f32x16{};o[3]=f32x16{};
  const int qrel=wid*QBLK+r32;
  #define CMASK(P0,P1,t) do{int jb_=(t)-(NT-4); if(jb_>=0)cmask(P0,P1,jb_,qrel,hi);}while(0)
  bool resc=false;
  #define START(P0,P1) do{ const float rm=rowmax(P0,P1); resc=false; \
    { const float dl=rm; mhat=fadd_s(mhat,dl); \
      _Pragma("unroll") for(int r=0;r<16;++r){P0[r]=fsub_s(P0[r],dl);P1[r]=fsub_s(P1[r],dl);} \
      } \
    _Pragma("unroll") for(int r=0;r<16;++r)P0[r]=__builtin_amdgcn_exp2f(P0[r]); }while(0)
  #define RESC() do{ if(resc){ asm volatile("s_waitcnt lgkmcnt(0)":::"memory"); \
      _Pragma("unroll") for(int r=0;r<16;++r){const float f_=wsf[crow(r,hi)]; o[0][r]*=f_;o[1][r]*=f_;o[2][r]*=f_;o[3][r]*=f_;} } }while(0)
  f32x16 pA0,pA1,pB0,pB1;
  int sl_prev=0,sl_cur=0,sl_next=SLOTB;
  #define ROT() do{sl_prev=sl_cur;sl_cur=sl_next;sl_next=(sl_next==(NSLOT-1)*SLOTB)?0:sl_next+SLOTB;}while(0)
  DMA_K(2,2*SLOTB);
  WAIT_BAR(4);
  qkt(pA0,pA1,Kbase,qr,f32x16{},r32,hi);asm volatile("s_nop 15\n\ts_nop 7":"+v"(pA0),"+v"(pA1));CMASK(pA0,pA1,0);
  START(pA0,pA1);
  _Pragma("unroll") for(int r=0;r<16;++r)pA1[r]=__builtin_amdgcn_exp2f(pA1[r]);
  #pragma unroll
  for(int d0=0;d0<4;++d0)*(__attribute__((address_space(3))) bf16x8*)(qp+d0*1024)=qr[d0];
  WAIT_BAR(0);
  DMA_K(3,0);DMA_V(1,SLOTB);
  ROT();
  kload8(kf,kp0+sl_cur);
  WAIT_BAR(3);
  s16x4 vlo[8],vhi[8],wlo[8],whi[8]; u32x4 pw0,pw1,pw2,pw3;
  #define PKW(P,B) cvtpk_s(P[B],P[B+1])
  #define PAF(k) __builtin_bit_cast(bf16x8,pw##k)
  #define VFR(i) (bf16x8){vlo[i][0],vlo[i][1],vlo[i][2],vlo[i][3],vhi[i][0],vhi[i][1],vhi[i][2],vhi[i][3]}
  #define PIN(x) asm volatile("":"+v"(x))
  #define MX3(a,b,c) __builtin_fmaxf(__builtin_fmaxf((a),(b)),(c))
  #define GAPA(MF,A0,A1,A2,A3,W0,W1,PW) do{ MF; sacc+=A0; sacc+=A1; sacc+=A2; sacc+=A3; PIN(sacc); W0; W1; PIN(PW); SBAR(); }while(0)
  #define EX(v) __builtin_amdgcn_exp2f(v)
  #define GAPB(MF,X,B) do{ MF; X[B]=EX(X[B]); X[B+1]=EX(X[B+1]); X[B+2]=EX(X[B+2]); X[B+3]=EX(X[B+3]); PIN(X); SBAR(); }while(0)
  #define GAPB2(MF,X,B) do{ MF; X[B]=EX(X[B]); X[B+1]=EX(X[B+1]); PIN(X); SBAR(); }while(0)
  #define WFR(i) (bf16x8){wlo[i][0],wlo[i][1],wlo[i][2],wlo[i][3],whi[i][0],whi[i][1],whi[i][2],whi[i][3]}
  #define WRD(i) do{ wlo[i]=vtr(vp_+(8192+((i)>>2)*4096+((i)&3)*1024)); whi[i]=vtr(vp_+(8192+((i)>>2)*4096+((i)&3)*1024+512)); }while(0)
  #define VRD(i) do{ vlo[i]=vtr(vp_+(((i)>>2)*4096+((i)&3)*1024)); vhi[i]=vtr(vp_+(((i)>>2)*4096+((i)&3)*1024+512)); }while(0)
  #define KRD(G,j) do{ if(G){ kload2(kf,kp0+sl_next,j); SBAR(); } }while(0)
  #define STEP(C0,C1,P0,P1,t,GK,GV,GL) do{ SBAR(); \
    const lds_cptr vp_=vp0+2*sl_prev; \
    bf16x8 qa=QLD(0),qb=QLD(1); VRD(0); SBAR(); float sacc=(P0[0]+P0[1]); \
    GAPA(C0=__builtin_amdgcn_mfma_f32_32x32x16_bf16(kf[0],qa,f32x16{},0,0,0), P0[2],P0[3],P0[4],P0[5],     pw0[0]=PKW(P0,0), pw0[1]=PKW(P0,2), pw0); \
    VRD(4); SBAR(); GAPA(C1=__builtin_amdgcn_mfma_f32_32x32x16_bf16(kf[1],qa,f32x16{},0,0,0), P0[6],P0[7],P0[8],P0[9],     pw0[2]=PKW(P0,4), pw0[3]=PKW(P0,6), pw0); \
    qa=QLD(2); VRD(1); SBAR(); GAPA(C0=__builtin_amdgcn_mfma_f32_32x32x16_bf16(kf[2],qb,C0,0,0,0),   P0[10],P0[11],P0[12],P0[13], pw1[0]=PKW(P0,8), pw1[1]=PKW(P0,10), pw1); \
    VRD(5); SBAR(); GAPA(C1=__builtin_amdgcn_mfma_f32_32x32x16_bf16(kf[3],qb,C1,0,0,0),   P0[14],P0[15],P1[0],P1[1],   pw1[2]=PKW(P0,12),pw1[3]=PKW(P0,14), pw1); \
    qb=QLD(3); VRD(2); SBAR(); GAPA(C0=__builtin_amdgcn_mfma_f32_32x32x16_bf16(kf[4],qa,C0,0,0,0),   P1[2],P1[3],P1[4],P1[5],     pw2[0]=PKW(P1,0), pw2[1]=PKW(P1,2), pw2); \
    VRD(6); SBAR(); GAPA(C1=__builtin_amdgcn_mfma_f32_32x32x16_bf16(kf[5],qa,C1,0,0,0),   P1[6],P1[7],P1[8],P1[9],     pw2[2]=PKW(P1,4), pw2[3]=PKW(P1,6), pw2); \
    VRD(3); SBAR(); GAPA(C0=__builtin_amdgcn_mfma_f32_32x32x16_bf16(kf[6],qb,C0,0,0,0),   P1[10],P1[11],P1[12],P1[13], pw3[0]=PKW(P1,8), pw3[1]=PKW(P1,10), pw3); \
    VRD(7); SBAR(); GAPA(C1=__builtin_amdgcn_mfma_f32_32x32x16_bf16(kf[7],qb,C1,0,0,0),   P1[14],P1[15],0.f,0.f,       pw3[2]=PKW(P1,12),pw3[3]=PKW(P1,14), pw3); \
    l_reg+=sacc; \
    _Pragma("unroll") for(int r=0;r<16;++r){C0[r]-=mhat;C1[r]-=mhat;} \
    if(GK){DMA_K((t)+3,sl_cur);} if(GV){DMA_V((t)+1,sl_next);} \
    CMASK(C0,C1,t); \
    { float a=MX3(C0[0],C0[1],C1[0]),b=MX3(C0[2],C0[3],C1[1]); a=MX3(a,C1[2],C1[3]); \
      _Pragma("unroll") for(int r=4;r<16;r+=4){a=MX3(a,C0[r],C0[r+1]);b=MX3(b,C0[r+2],C0[r+3]);a=MX3(a,C1[r],C1[r+1]);b=MX3(b,C1[r+2],C1[r+3]);} \
      float rm=__builtin_fmaxf(a,b); { auto rr=__builtin_amdgcn_permlane32_swap(__float_as_uint(rm),__float_as_uint(rm),false,false); rm=__builtin_fmaxf(__uint_as_float(rr[0]),__uint_as_float(rr[1])); } \
      resc=false; \
      if(__builtin_expect(__any(rm>(float)THRL),0)){ const float dl=__builtin_fmaxf(rm,0.f); mhat+=dl; \
        _Pragma("unroll") for(int r=0;r<16;++r){C0[r]-=dl;C1[r]-=dl;} \
        const float f=__builtin_amdgcn_exp2f(-dl); l_reg*=f; if(hi==0)wsf[r32]=f; resc=true; } } \
    SBAR(); \
    GAPB2(o[0]=__builtin_amdgcn_mfma_f32_32x32x16_bf16(PAF(0),VFR(0),o[0],0,0,0), C0,0); \
    GAPB2(o[1]=__builtin_amdgcn_mfma_f32_32x32x16_bf16(PAF(0),VFR(4),o[1],0,0,0), C0,2); \
    KRD(GL,0); GAPB2(o[0]=__builtin_amdgcn_mfma_f32_32x32x16_bf16(PAF(1),VFR(1),o[0],0,0,0), C0,4); \
    KRD(GL,1); GAPB2(o[1]=__builtin_amdgcn_mfma_f32_32x32x16_bf16(PAF(1),VFR(5),o[1],0,0,0), C0,6); \
    KRD(GL,2); WRD(0); SBAR(); GAPB2(o[0]=__builtin_amdgcn_mfma_f32_32x32x16_bf16(PAF(2),VFR(2),o[0],0,0,0), C0,8); \
    KRD(GL,3); WRD(4); SBAR(); GAPB2(o[1]=__builtin_amdgcn_mfma_f32_32x32x16_bf16(PAF(2),VFR(6),o[1],0,0,0), C0,10); \
    WRD(1); SBAR(); GAPB2(o[0]=__builtin_amdgcn_mfma_f32_32x32x16_bf16(PAF(3),VFR(3),o[0],0,0,0), C0,12); \
    WRD(5); SBAR(); GAPB2(o[1]=__builtin_amdgcn_mfma_f32_32x32x16_bf16(PAF(3),VFR(7),o[1],0,0,0), C0,14); \
    WRD(2); SBAR(); GAPB2(o[2]=__builtin_amdgcn_mfma_f32_32x32x16_bf16(PAF(0),WFR(0),o[2],0,0,0), C1,0); \
    WRD(6); SBAR(); GAPB2(o[3]=__builtin_amdgcn_mfma_f32_32x32x16_bf16(PAF(0),WFR(4),o[3],0,0,0), C1,2); \
    WRD(3); SBAR(); GAPB2(o[2]=__builtin_amdgcn_mfma_f32_32x32x16_bf16(PAF(1),WFR(1),o[2],0,0,0), C1,4); \
    WRD(7); SBAR(); GAPB2(o[3]=__builtin_amdgcn_mfma_f32_32x32x16_bf16(PAF(1),WFR(5),o[3],0,0,0), C1,6); \
    GAPB2(o[2]=__builtin_amdgcn_mfma_f32_32x32x16_bf16(PAF(2),WFR(2),o[2],0,0,0), C1,8); \
    GAPB2(o[3]=__builtin_amdgcn_mfma_f32_32x32x16_bf16(PAF(2),WFR(6),o[3],0,0,0), C1,10); \
    GAPB2(o[2]=__builtin_amdgcn_mfma_f32_32x32x16_bf16(PAF(3),WFR(3),o[2],0,0,0), C1,12); \
    GAPB2(o[3]=__builtin_amdgcn_mfma_f32_32x32x16_bf16(PAF(3),WFR(7),o[3],0,0,0), C1,14); \
    }while(0)
  int t=1;
  #undef CMASK
  #define CMASK(P0,P1,t) do{}while(0)
  for(;t+5<NT;t+=2){
    STEP(pB0,pB1,pA0,pA1,t,true,true,true);     WAIT_BAR(3); RESC(); ROT();
    STEP(pA0,pA1,pB0,pB1,t+1,true,true,true);   WAIT_BAR(3); RESC(); ROT();
  }
  #undef CMASK
  #define CMASK(P0,P1,t) do{int jb_=(t)-(NT-4); if(jb_>=0)cmask(P0,P1,jb_,qrel,hi);}while(0)
  #define ENDW(tt) do{ if((tt)+3<NT){WAIT_BAR(3);} else if((tt)+2<NT){WAIT_BAR(2);} else {WAIT_BAR(0);} }while(0)
  for(;t+1<NT;t+=2){
    STEP(pB0,pB1,pA0,pA1,t,(t+3<NT),(t+1<NT),(t+1<NT));       ENDW(t);   RESC(); ROT();
    STEP(pA0,pA1,pB0,pB1,t+1,(t+4<NT),(t+2<NT),(t+2<NT));     ENDW(t+1); RESC(); ROT();
  }
  STEP(pB0,pB1,pA0,pA1,NT-1,false,false,false); RESC();
  { float sacc=pB0[0]+pB0[1]; _Pragma("unroll") for(int r=2;r<16;++r)sacc+=pB0[r]; _Pragma("unroll") for(int r=0;r<16;++r)sacc+=pB1[r]; l_reg+=sacc;
    pw0=(u32x4){PKW(pB0,0),PKW(pB0,2),PKW(pB0,4),PKW(pB0,6)};pw1=(u32x4){PKW(pB0,8),PKW(pB0,10),PKW(pB0,12),PKW(pB0,14)};pw2=(u32x4){PKW(pB1,0),PKW(pB1,2),PKW(pB1,4),PKW(pB1,6)};pw3=(u32x4){PKW(pB1,8),PKW(pB1,10),PKW(pB1,12),PKW(pB1,14)};
    SBAR(); pv(o,vb0+2*sl_cur,PAF(0),PAF(1),PAF(2),PAF(3)); pv(o+2,vb0+2*sl_cur+8192,PAF(0),PAF(1),PAF(2),PAF(3)); }
  #undef PKW
  #undef PAF
  #undef VFR
  #undef PIN
  #undef MX3
  #undef GAPA
  #undef GAPB
  #undef GAPB2
  #undef QLD
  #undef WFR
  #undef WRD
  #undef EX
  #undef VRD
  #undef KRD
  #undef STEP
  #undef ENDW
  {auto rr=__builtin_amdgcn_permlane32_swap(__float_as_uint(l_reg),__float_as_uint(l_reg),false,false);l_reg=__uint_as_float(rr[0])+__uint_as_float(rr[1]);}
  if(hi==0)wsf[32+r32]=l_reg;asm volatile("s_waitcnt lgkmcnt(0)":::"memory");
  #pragma unroll
  for(int r=0;r<16;++r){const float rl=__builtin_amdgcn_rcpf(wsf[32+crow(r,hi)]); o[0][r]*=rl;o[1][r]*=rl;o[2][r]*=rl;o[3][r]*=rl;}
  float*st=stash+(size_t)(wid*64)*64+lane;
  if(m==0){
    #pragma unroll
    for(int k=0;k<64;++k)st[k*64]=o[k>>4][k&15];
  }else{
    #pragma unroll
    for(int k=0;k<64;++k)o[k>>4][k&15]=st[k*64]-lam*o[k>>4][k&15];
    #pragma unroll
    for(int r=0;r<16;++r){
      float ss=o[0][r]*o[0][r]+o[1][r]*o[1][r]+o[2][r]*o[2][r]+o[3][r]*o[3][r];
      ss+=__shfl_xor(ss,1);ss+=__shfl_xor(ss,2);ss+=__shfl_xor(ss,4);ss+=__shfl_xor(ss,8);ss+=__shfl_xor(ss,16);
      const float rs=1.0f/sqrtf(ss*(1.0f/128.0f)+1e-5f);
      o[0][r]*=rs;o[1][r]*=rs;o[2][r]*=rs;o[3][r]*=rs;}
    float*stg=(float*)(shm+L2_OST)+wid*1024;
    bf16*Gw=GO+(rowbase+q0+wid*QBLK)*DM+h*128;
    #pragma unroll
    for(int d0=0;d0<4;++d0){
      #pragma unroll
      for(int r=0;r<16;++r)stg[crow(r,hi)*32+r32]=o[d0][r];
      asm volatile("s_waitcnt lgkmcnt(0)":::"memory");
      #pragma unroll
      for(int i=0;i<2;++i){const int row=i*16+(lane>>2),ch=lane&3; const float4 va=*(const float4*)(stg+row*32+ch*8), vb_=*(const float4*)(stg+row*32+ch*8+4);
        bf16*gp=Gw+(long)row*DM+d0*32+ch*8; const u32x4 gt=*(const u32x4*)gp;
        const float4 s0=*(const float4*)(subg+d0*32+ch*8), s1=*(const float4*)(subg+d0*32+ch*8+4);
        const float vv[8]={va.x,va.y,va.z,va.w,vb_.x,vb_.y,vb_.z,vb_.w}; const float sg[8]={s0.x,s0.y,s0.z,s0.w,s1.x,s1.y,s1.z,s1.w}; float rr_[8];
        #pragma unroll
        for(int e=0;e<4;++e){ const unsigned gw=gt[e]; const float g0=__uint_as_float(gw<<16), g1=__uint_as_float(gw&0xffff0000u);
          rr_[2*e]=vv[2*e]*sg[2*e]*0.8f*g0/(1.0f+__expf(-g0)); rr_[2*e+1]=vv[2*e+1]*sg[2*e+1]*0.8f*g1/(1.0f+__expf(-g1)); }
        u32x4 ov; ov[0]=cvtpk_s(rr_[0],rr_[1]); ov[1]=cvtpk_s(rr_[2],rr_[3]); ov[2]=cvtpk_s(rr_[4],rr_[5]); ov[3]=cvtpk_s(rr_[6],rr_[7]);
        *(u32x4*)gp=ov; }
      asm volatile("s_waitcnt lgkmcnt(0)":::"memory");
    }
  }
  asm volatile("s_waitcnt lgkmcnt(0)\n\ts_barrier":::"memory");
  #undef DMA_K
  #undef DMA_V
  #undef CMASK
  #undef START
  #undef RESC
  #undef ROT
}
#undef SBAR
#undef WAIT_BAR
}
#ifndef PG8_SP2
#define PG8_SP2 true
#endif
#ifndef PG8_ALIGN
#define PG8_ALIGN true
#endif
#ifndef ATTN_SIMPLE
#define ATTN_UNIT attn_unit3<8>
#else
#define ATTN_UNIT attn_unit2
#endif
#include <hip/hip_cooperative_groups.h>
namespace cg = cooperative_groups;
#define LAS __attribute__((address_space(3)))
#define GAS __attribute__((address_space(1)))
typedef unsigned short bf16;
typedef unsigned v4u __attribute__((ext_vector_type(4)));
typedef unsigned v2u __attribute__((ext_vector_type(2)));
typedef float f32x4 __attribute__((ext_vector_type(4)));
typedef short bf16x8 __attribute__((ext_vector_type(8)));
#define LDS_WAIT() asm volatile("s_waitcnt lgkmcnt(0)" ::: "memory")
constexpr int NWAVES = 8;
constexpr int BATCH = 8, SEQ = 4096, D = 1024, M = BATCH * SEQ, NPROJ = 8192;
constexpr float LN_EPS = 1e-5f;
constexpr size_t MiB = 1u << 20;
constexpr size_t WS_CTL = 0, CTL_ZERO_BYTES = 65536;
constexpr size_t WS_WIN = 2 * MiB, WS_WAP = 18 * MiB, WS_WRP = 20 * MiB, WS_WOUT = 22 * MiB, WS_ROPE = 24 * MiB;
constexpr size_t WS_S0 = 32 * MiB, SLOT = 64 * MiB;
constexpr size_t WS_STASH = 480 * MiB, WS_END = 512 * MiB;
constexpr int RING_BYTES = 131072, LDS_BYTES = 147456;
static_assert(attn_body::LDS_BYTES <= RING_BYTES && attn_body::LDS2_BYTES <= RING_BYTES && pg8::STAGE_BYTES <= RING_BYTES, "LDS map");

__device__ __forceinline__ unsigned f2bf(float f) { unsigned u = __builtin_bit_cast(unsigned, f); return (u + 0x7fffu + ((u >> 16) & 1u)) >> 16; }
__device__ __forceinline__ unsigned pk2(float lo, float hi) { return f2bf(lo) | (f2bf(hi) << 16); }
__device__ __forceinline__ float bfu(unsigned short h) { return __builtin_bit_cast(float, (unsigned)h << 16); }
__device__ __forceinline__ float wave_sum(float v) {
#pragma unroll
    for (int o = 1; o < 64; o <<= 1) v += __shfl_xor(v, o);
    return v;
}
__device__ __forceinline__ void p0_transpose_item(const float* W, int K, int N, bf16* WT, LAS float* scr, int item, int lane) {
    const int nblk = N / 32, kb = item / nblk, nb = item % nblk, k0 = 64 * kb, n0 = 32 * nb;
#pragma unroll 8
    for (int i = 0; i < 32; ++i) { const int kk = 2 * i + (lane >> 5); scr[kk * 33 + (lane & 31)] = W[(size_t)(k0 + kk) * N + n0 + (lane & 31)]; }
    LDS_WAIT(); asm volatile("" ::: "memory");
    const int c = lane & 7;
#pragma unroll
    for (int j = 0; j < 4; ++j) { const int n = (lane >> 3) + 8 * j; const LAS float* s = scr + (8 * c) * 33 + n;
        v4u o; o.x = pk2(s[0 * 33], s[1 * 33]); o.y = pk2(s[2 * 33], s[3 * 33]); o.z = pk2(s[4 * 33], s[5 * 33]); o.w = pk2(s[6 * 33], s[7 * 33]);
        *(GAS v4u*)(WT + (size_t)(n0 + n) * K + k0 + 8 * c) = o; }
    LDS_WAIT(); asm volatile("" ::: "memory");
}

#define XB_TMO      128
#define XB_XCNT(j)  (256  + 64 * (j))
#define XB_XSUB(j)  (1280 + 64 * (j))
#define XB_XGEN(j)  (2304 + 64 * (j))
#define XB_TOP      3328
#define XB_TOPGEN   3392
#define XCD_BAR_WORDS 3456
#define XB_SPIN_CAP (1u << 18)

__device__ __forceinline__ unsigned xb_ld(unsigned* p)              { return __hip_atomic_load(p, __ATOMIC_RELAXED, __HIP_MEMORY_SCOPE_AGENT); }
__device__ __forceinline__ unsigned xb_add(unsigned* p, unsigned v) { return __hip_atomic_fetch_add(p, v, __ATOMIC_RELAXED, __HIP_MEMORY_SCOPE_AGENT); }
__device__ __forceinline__ unsigned xb_xcc_id() { return (unsigned)__builtin_amdgcn_s_getreg((3 << 11) | 20) & 0xFu; }
#define XB_SPIN(cond, bar) do { unsigned _sp = 0; while (cond) { __builtin_amdgcn_s_sleep(1); \
    if ((++_sp & 255u) == 0u) { if (xb_ld(&(bar)[XB_TMO])) break; if (_sp > XB_SPIN_CAP) { atomicAdd(&(bar)[XB_TMO], 1u); break; } } } } while (0)

struct XcdBarrier {
    unsigned* bar; unsigned x;
    volatile LAS unsigned* st;
};

__device__ __forceinline__ XcdBarrier xcd_barrier_post(unsigned* bar, volatile LAS unsigned* st) {
    XcdBarrier b; b.bar = bar; b.x = xb_xcc_id(); b.st = st;
    if (threadIdx.x == 0) (void)xb_add(&bar[XB_XCNT(b.x)], 1u);
    return b;
}
__device__ __forceinline__ void xcd_barrier_complete(unsigned* bar, unsigned x, unsigned& nloc, unsigned& nx) {
    const unsigned G = gridDim.x * gridDim.y * gridDim.z;
    unsigned sum, cnt, mine, sp = 0u;
    for (;;) {
        sum = 0u; cnt = 0u; mine = 0u;
#pragma unroll
        for (unsigned j = 0; j < 16; ++j) { const unsigned c = xb_ld(&bar[XB_XCNT(j)]); sum += c; cnt += (c > 0u) ? 1u : 0u; mine = (j == x) ? c : mine; }
        if (sum == G) break;
        __builtin_amdgcn_s_sleep(1);
        if ((++sp & 255u) == 0u) { if (xb_ld(&bar[XB_TMO])) break; if (sp > XB_SPIN_CAP) { atomicAdd(&bar[XB_TMO], 1u); break; } }
    }
    nloc = mine > 0u ? mine : 1u; nx = cnt > 0u ? cnt : 1u;
}

__device__ __forceinline__ void xcd_barrier(const XcdBarrier& b) {
    asm volatile("s_waitcnt vmcnt(0)" ::: "memory");
    __syncthreads();
    if (threadIdx.x == 0) {
        unsigned* bar = b.bar;
        __builtin_amdgcn_s_waitcnt(0);
        unsigned nloc = b.st[0], nx = b.st[1];
        if (nloc == 0u) { xcd_barrier_complete(bar, b.x, nloc, nx); b.st[0] = nloc; b.st[1] = nx; }
        const unsigned old = xb_add(&bar[XB_XSUB(b.x)], 1u);
        const unsigned gen = old / nloc;
        if (old + 1u == (gen + 1u) * nloc) {
            __builtin_amdgcn_fence(__ATOMIC_RELEASE, "agent");
            asm volatile("s_waitcnt vmcnt(0)" ::: "memory");
            const unsigned og = xb_add(&bar[XB_TOP], 1u);
            const unsigned tg = og / nx;
            if (og + 1u == (tg + 1u) * nx) xb_add(&bar[XB_TOPGEN], 1u);
            else XB_SPIN(xb_ld(&bar[XB_TOPGEN]) == tg, bar);
            __builtin_amdgcn_fence(__ATOMIC_ACQUIRE, "agent");
            xb_add(&bar[XB_XGEN(b.x)], 1u);
            asm volatile("s_waitcnt vmcnt(0)" ::: "memory");
        } else {
            XB_SPIN(xb_ld(&bar[XB_XGEN(b.x)]) == gen, bar);
            __builtin_amdgcn_fence(__ATOMIC_ACQUIRE, "agent");
            asm volatile("s_waitcnt vmcnt(0)" ::: "memory");
        }
    }
    __syncthreads();
}


struct Args { const float* in[20]; float* out; unsigned char* ws; };

__device__ __forceinline__ void p0_prologue(const float* x, const float* w_in, const float* w_ap, const float* w_rp, const float* w_out, bf16* Win_t, bf16* Wap_t, bf16* Wrp_t, bf16* Wout_t, bf16* XB, float* rope,
                                            LAS unsigned char* lds, int vcu, int G, int wave, int lane) {
    LAS float* scr = (LAS float*)(lds + wave * 16384);
    const int gw = vcu * NWAVES + wave, NGW = G * NWAVES;
    constexpr int I_IN = (D / 64) * (NPROJ / 32), I_SQ = (D / 64) * (D / 32);
    constexpr int NITEMS = I_IN + 3 * I_SQ;
    for (int it = gw; it < NITEMS; it += NGW) {
        int r = it;
        if (r < I_IN) { p0_transpose_item(w_in, D, NPROJ, Win_t, scr, r, lane); continue; } r -= I_IN;
        if (r < I_SQ) { p0_transpose_item(w_ap, D, D, Wap_t, scr, r, lane); continue; } r -= I_SQ;
        if (r < I_SQ) { p0_transpose_item(w_rp, D, D, Wrp_t, scr, r, lane); continue; } r -= I_SQ;
        p0_transpose_item(w_out, D, D, Wout_t, scr, r, lane);
    }
    for (int m = gw; m < M; m += NGW) {
        const GAS f32x4* xr = (const GAS f32x4*)(x + (size_t)m * D) + lane;
        GAS v2u* o8 = (GAS v2u*)(XB + (size_t)m * D) + lane;
#pragma unroll
        for (int j = 0; j < 4; ++j) { const f32x4 v = xr[64 * j]; v2u w; w.x = pk2(v.x, v.y); w.y = pk2(v.z, v.w); o8[64 * j] = w; }
    }
    for (int e = gw * 64 + lane; e < SEQ * 8; e += NGW * 64) {
        const int pos = e >> 3, j = e & 7;
        const float inv = j == 0 ? 1.0f : j == 1 ? 0.1939227432012558f : j == 2 ? 0.03760603070259094f : j == 3 ? 0.007292664609849453f : j == 4 ? 0.0014142135623842478f
                        : j == 5 ? 0.00027424818836152554f : j == 6 ? 5.318296098266728e-05f : 1.0313386155758053e-05f;
        const float angf = (float)pos * inv;
        const double a = (double)angf, kk = __builtin_rint(a * 0.15915494309189535), r = a - kk * 6.283185307179586;
        const double x2 = r * r; double ts = r, tc = 1.0, sn = r, cs = 1.0;
#pragma unroll
        for (int n = 1; n <= 14; ++n) { tc *= -x2 * (1.0 / (double)((2 * n - 1) * (2 * n))); cs += tc; ts *= -x2 * (1.0 / (double)((2 * n) * (2 * n + 1))); sn += ts; }
        rope[pos * 16 + j] = (float)cs; rope[pos * 16 + 8 + j] = (float)sn;
    }
}

constexpr int RN_A = 0, RN_XCF = 34816, RN_AL = 51200, RN_UL = 68096, RN_SP = 84992, RN_SH = 87040, RN_CARRY = 89088;
__device__ __forceinline__ void rnn_unit(int b, int n, int q, const bf16* XR, bf16* GH, bf16* HO, const float* conv_w, const float* conv_b, const float* w_a, const float* b_a, const float* w_x, const float* b_x,
                                         const float* lru_lambda, LAS unsigned char* lds) {
    int tid = threadIdx.x; asm volatile("" : "+v"(tid)); const int lane = tid & 63, wave = __builtin_amdgcn_readfirstlane(tid >> 6);
    const int d0 = q * 32, chb = n * 128;
    const int c8 = tid & 15, tg = tid >> 4;
    float cw[4][8], cb[8];
#pragma unroll
    for (int e = 0; e < 8; ++e) { cb[e] = conv_b[chb + c8 * 8 + e];
#pragma unroll
        for (int j = 0; j < 4; ++j) cw[j][e] = conv_w[j * 1024 + chb + c8 * 8 + e]; }
    const int fr = lane & 15, quad = lane >> 4;
    bf16x8 bfr[4][4];
#pragma unroll
    for (int nt = 0; nt < 4; ++nt) { const float* Wg = (nt < 2 ? w_a : w_x) + (size_t)n * 16384 + d0 + (nt & 1) * 16 + fr;
#pragma unroll
        for (int ks = 0; ks < 4; ++ks) { bf16x8 f;
#pragma unroll
            for (int j = 0; j < 8; ++j) f[j] = (short)f2bf(Wg[(size_t)(ks * 32 + quad * 8 + j) * 128]);
            bfr[nt][ks] = f; } }
    float ba[2], bx[2], sp[2];
#pragma unroll
    for (int h2 = 0; h2 < 2; ++h2) { const int ch = chb + d0 + h2 * 16 + fr; ba[h2] = b_a[ch]; bx[h2] = b_x[ch]; sp[h2] = log1pf(__expf(-lru_lambda[ch])); }
    const int dl = tid & 31, seg = tid >> 5;
    LAS unsigned char* A_l = lds + RN_A; LAS float* xcf = (LAS float*)(lds + RN_XCF); LAS float* aL = (LAS float*)(lds + RN_AL); LAS float* uL = (LAS float*)(lds + RN_UL);
    LAS float* sP = (LAS float*)(lds + RN_SP); LAS float* sH = (LAS float*)(lds + RN_SH); LAS float* carry = (LAS float*)(lds + RN_CARRY);
    if (tid < 64) carry[tid] = 0.f;
    const size_t rowbase = (size_t)b * SEQ;
    v4u raw[7];
#pragma unroll
    for (int i = 0; i < 7; ++i) { const int tp = tg * 4 - 3 + i; raw[i] = (v4u){0u, 0u, 0u, 0u}; if (tp >= 0) raw[i] = *(const GAS v4u*)(XR + (rowbase + tp) * 1024 + chb + c8 * 8); }
    for (int ck = 0; ck < SEQ / 128; ++ck) {
        const int t0 = ck * 128;
        {
            float xr[7][8];
#pragma unroll
            for (int i = 0; i < 7; ++i) { xr[i][0] = pg8::bf_lo(raw[i].x); xr[i][1] = pg8::bf_hi(raw[i].x); xr[i][2] = pg8::bf_lo(raw[i].y); xr[i][3] = pg8::bf_hi(raw[i].y);
                                          xr[i][4] = pg8::bf_lo(raw[i].z); xr[i][5] = pg8::bf_hi(raw[i].z); xr[i][6] = pg8::bf_lo(raw[i].w); xr[i][7] = pg8::bf_hi(raw[i].w); }
#pragma unroll
            for (int tl = 0; tl < 4; ++tl) { float xc[8];
#pragma unroll
                for (int e = 0; e < 8; ++e) { float v = cb[e];
#pragma unroll
                    for (int j = 0; j < 4; ++j) v += cw[j][e] * xr[tl + j][e];
                    xc[e] = v; }
                const int t = tg * 4 + tl;
                v4u w; w.x = pk2(xc[0], xc[1]); w.y = pk2(xc[2], xc[3]); w.z = pk2(xc[4], xc[5]); w.w = pk2(xc[6], xc[7]);
                *(LAS v4u*)(A_l + t * 272 + c8 * 16) = w;
                if ((c8 >> 2) == q) { LAS f32x4* xp = (LAS f32x4*)(xcf + t * 32 + (c8 & 3) * 8); xp[0] = (f32x4){xc[0], xc[1], xc[2], xc[3]}; xp[1] = (f32x4){xc[4], xc[5], xc[6], xc[7]}; }
            }
        }
        if (ck + 1 < SEQ / 128) {
#pragma unroll
            for (int i = 0; i < 7; ++i) { const int tp = t0 + 128 + tg * 4 - 3 + i; raw[i] = *(const GAS v4u*)(XR + (rowbase + tp) * 1024 + chb + c8 * 8); }
        }
        const size_t goff = (rowbase + t0 + seg * 8) * 1024 + chb + d0 + dl; const bf16* gp = GH + goff; bf16* hp = HO + goff;
        unsigned short gv[8];
#pragma unroll
        for (int i = 0; i < 8; ++i) gv[i] = gp[(size_t)i * 1024];
        __syncthreads();
        f32x4 acc[4];
#pragma unroll
        for (int nt = 0; nt < 4; ++nt) acc[nt] = (f32x4){0.f, 0.f, 0.f, 0.f};
#pragma unroll
        for (int ks = 0; ks < 4; ++ks) { const bf16x8 af = *(const LAS bf16x8*)(A_l + (wave * 16 + fr) * 272 + ks * 64 + quad * 16);
#pragma unroll
            for (int nt = 0; nt < 4; ++nt) acc[nt] = __builtin_amdgcn_mfma_f32_16x16x32_bf16(af, bfr[nt][ks], acc[nt], 0, 0, 0); }
#pragma unroll
        for (int h2 = 0; h2 < 2; ++h2)
#pragma unroll
            for (int j = 0; j < 4; ++j) { const int t = wave * 16 + quad * 4 + j, cl = h2 * 16 + fr;
                const float r = 1.f / (1.f + __expf(-(acc[h2][j] + ba[h2]))), ig = 1.f / (1.f + __expf(-(acc[2 + h2][j] + bx[h2])));
                const float la = -8.f * r * sp[h2], av = __expf(la), y = 2.f * la;
                const float em1 = y * (1.f + y * (0.5f + y * (1.f / 6.f + y * (1.f / 24.f + y * (1.f / 120.f + y * (1.f / 720.f + y * (1.f / 5040.f)))))));
                const float uv = sqrtf(-em1) * ig * xcf[t * 32 + cl];
                aL[t * 33 + cl] = av; uL[t * 33 + cl] = uv; }
        __syncthreads();
        float as_[8], us_[8]; float P = 1.f, H = 0.f;
#pragma unroll
        for (int i = 0; i < 8; ++i) { as_[i] = aL[(seg * 8 + i) * 33 + dl]; us_[i] = uL[(seg * 8 + i) * 33 + dl]; H = as_[i] * H + us_[i]; P *= as_[i]; }
        sP[seg * 32 + dl] = P; sH[seg * 32 + dl] = H;
        __syncthreads();
        float h = carry[(ck & 1) * 32 + dl];
        for (int s = 0; s < seg; ++s) h = sP[s * 32 + dl] * h + sH[s * 32 + dl];
#pragma unroll
        for (int i = 0; i < 8; ++i) { h = as_[i] * h + us_[i]; const float g = bfu(gv[i]); hp[(size_t)i * 1024] = (bf16)f2bf(h * g / (1.f + __expf(-g))); }
        if (seg == 15) carry[((ck + 1) & 1) * 32 + dl] = h;
        __syncthreads();
    }
}

__device__ __forceinline__ void ln_row_inplace(float* row, const float* g, const float* bta, int lane) {
    GAS f32x4* xr = (GAS f32x4*)row + lane;
    f32x4 v[4]; float s = 0.f;
#pragma unroll
    for (int j = 0; j < 4; ++j) { v[j] = xr[64 * j]; s += (v[j].x + v[j].y) + (v[j].z + v[j].w); }
    const float mean = wave_sum(s) * (1.f / D); float s2 = 0.f;
#pragma unroll
    for (int j = 0; j < 4; ++j) { v[j] = v[j] - mean; s2 += (v[j].x * v[j].x + v[j].y * v[j].y) + (v[j].z * v[j].z + v[j].w * v[j].w); }
    const float rstd = 1.f / sqrtf(wave_sum(s2) * (1.f / D) + LN_EPS);
#pragma unroll
    for (int j = 0; j < 4; ++j) { const f32x4 gg = *((const GAS f32x4*)g + lane + 64 * j), bb = *((const GAS f32x4*)bta + lane + 64 * j); xr[64 * j] = v[j] * rstd * gg + bb; }
}

__global__ void __launch_bounds__(NWAVES * 64, 2) fwd_megakernel(Args args) {
    extern __shared__ __attribute__((aligned(16))) unsigned char lds[];
    cg::grid_group grid = cg::this_grid();
    LAS unsigned char* L = (LAS unsigned char*)lds;
    const int tid = threadIdx.x, lane = tid & 63, wave = __builtin_amdgcn_readfirstlane(tid >> 6);
    const int G = gridDim.x; const int bx = blockIdx.x; const int vcu = (G % 8 == 0) ? (bx % 8) * (G / 8) + bx / 8 : bx;
    unsigned char* ws = args.ws;
    const float* x = args.in[0];
    volatile LAS unsigned* MISC = (volatile LAS unsigned*)(L + RING_BYTES + 320);
    if (tid < 32) MISC[tid] = 0u;
    __syncthreads();
    XcdBarrier xbar = xcd_barrier_post((unsigned*)(ws + WS_CTL) + 4096, MISC + 8);

    bf16* Win_t = (bf16*)(ws + WS_WIN); bf16* Wap_t = (bf16*)(ws + WS_WAP); bf16* Wrp_t = (bf16*)(ws + WS_WRP); bf16* Wout_t = (bf16*)(ws + WS_WOUT); float* rope = (float*)(ws + WS_ROPE);
    bf16* S0 = (bf16*)(ws + WS_S0);
    bf16* S1 = (bf16*)(ws + WS_S0 + 1 * SLOT);
    bf16* S2 = (bf16*)(ws + WS_S0 + 2 * SLOT);
    bf16* S3 = (bf16*)(ws + WS_S0 + 3 * SLOT);
    bf16* S4 = (bf16*)(ws + WS_S0 + 4 * SLOT);
    bf16* S5 = (bf16*)(ws + WS_S0 + 5 * SLOT);
    bf16* S6 = (bf16*)(ws + WS_S0 + 6 * SLOT);
    bf16* D0 = (bf16*)args.out;
    bf16* D1 = D0 + (size_t)M * D;
    float* stash = (float*)(ws + WS_STASH) + (size_t)bx * 32768;

    p0_prologue(x, args.in[1], args.in[15], args.in[16], args.in[17], Win_t, Wap_t, Wrp_t, Wout_t, D0, rope, L, vcu, G, wave, lane);
    grid.sync();
#ifdef PROBE_SYNC
    grid.sync(); grid.sync(); grid.sync(); grid.sync();
#endif
    {
        pg8::Gemm g{D0, Win_t, M, NPROJ, D, nullptr, nullptr}; pg8::StaticOrder S; S.init(M, NPROJ, G, bx);
        pg8::EpiProj E{S0, S1, S2, S3, S4, S5, S6, D1, rope, attn_body::C2, SEQ - 1};
        pg8::gemm_phase<pg8::EpiProj, pg8::StaticOrder, PG8_ALIGN, PG8_SP2>(L, g, S, E);
#ifdef PROBE_P1X2
        __syncthreads();
        pg8::gemm_phase<pg8::EpiProj, pg8::StaticOrder, PG8_ALIGN, PG8_SP2>(L, g, S, E);
#endif
    }
    xcd_barrier(xbar);
#ifndef NO_RNN
#ifdef PROBE_RNN2
    for (int u = vcu; u < 256; u += G)
        rnn_unit(u >> 5, (u >> 2) & 7, u & 3, S4, S5, D0, args.in[7], args.in[8], args.in[9], args.in[10], args.in[11], args.in[12], args.in[13], L);
#endif
    for (int u = vcu; u < 256; u += G)
        rnn_unit(u >> 5, (u >> 2) & 7, u & 3, S4, S5, S5, args.in[7], args.in[8], args.in[9], args.in[10], args.in[11], args.in[12], args.in[13], L);
#endif
#ifndef NO_ATT
    {
        const float l1 = wave_sum(args.in[2][lane] * args.in[3][lane]), l2 = wave_sum(args.in[4][lane] * args.in[5][lane]);
        const float lam = __builtin_bit_cast(float, __builtin_amdgcn_readfirstlane(__builtin_bit_cast(int, __expf(l1) - __expf(l2) + 0.2f)));
        for (int u = vcu; u < 1024; u += G) {
            const int w = u & 255, i = u >> 8, bh = w >> 2, s = w & 3;
            const int qb = (i == 0) ? s : (i == 1) ? 7 - s : (i == 2) ? 8 + s : 15 - s;
#ifdef ATTN_4PASS
            for (int p = 0; p < 4; ++p)
                attn_body::attn_unit<8>(bh >> 3, bh & 7, qb, p, lam, (const attn_body::bf16*)S0, (const attn_body::bf16*)S1, (const attn_body::bf16*)S2, (attn_body::bf16*)S3, args.in[6], stash, (char*)lds);
#else
#ifdef PROBE_ATT
            for (int p = -1; p < 2; ++p)
                attn_body::ATTN_UNIT(bh >> 3, bh & 7, qb, p < 0 ? 0 : p, lam, (const attn_body::bf16*)S0, (const attn_body::bf16*)S1, (const attn_body::bf16*)S2, (attn_body::bf16*)S3, args.in[6], stash, (char*)lds);
#else
            for (int p = 0; p < 2; ++p)
                attn_body::ATTN_UNIT(bh >> 3, bh & 7, qb, p, lam, (const attn_body::bf16*)S0, (const attn_body::bf16*)S1, (const attn_body::bf16*)S2, (attn_body::bf16*)S3, args.in[6], stash, (char*)lds);
#endif
#endif
        }
    }
#endif
    xcd_barrier(xbar);
    {
        pg8::Gemm g{S3, Wap_t, M, D, D, S5, Wrp_t}; pg8::DualOrder S; S.init(M, D, G, bx);
        pg8::EpiMerge E{S6, D1, args.in[14], S0};
        pg8::gemm_phase<pg8::EpiMerge, pg8::DualOrder, PG8_ALIGN, PG8_SP2>(L, g, S, E);
#ifdef PROBE_P3A
        __syncthreads();
        pg8::gemm_phase<pg8::EpiMerge, pg8::DualOrder, PG8_ALIGN, PG8_SP2>(L, g, S, E);
#endif
    }
    xcd_barrier(xbar);
    {
        pg8::Gemm g{S0, Wout_t, M, D, D, nullptr, nullptr}; pg8::StaticOrder S; S.init(M, D, G, bx);
        pg8::EpiResF32 E{x, args.out, 1.189207115002721f};
        pg8::gemm_phase<pg8::EpiResF32, pg8::StaticOrder, PG8_ALIGN, PG8_SP2>(L, g, S, E);
#ifdef PROBE_P3B
        __syncthreads();
        pg8::gemm_phase<pg8::EpiResF32, pg8::StaticOrder, PG8_ALIGN, PG8_SP2>(L, g, S, E);
#endif
    }
    xcd_barrier(xbar);
    { int t4 = threadIdx.x; asm volatile("" : "+v"(t4)); const int lane4 = t4 & 63, wave4 = __builtin_amdgcn_readfirstlane(t4 >> 6);
    for (int m = vcu * NWAVES + wave4; m < M; m += G * NWAVES) ln_row_inplace(args.out + (size_t)m * D, args.in[18], args.in[19], lane4); }
}

extern "C" void kernel_launch(void* const* d_in, const int* in_sizes, int n_in, void* d_out, int out_size, void* d_ws, size_t ws_size, hipStream_t stream) {
    static int grid = 0;
    if (grid == 0) {
        if (n_in != 20 || in_sizes[0] != M * D || out_size != M * D || ws_size < WS_END) { fprintf(stderr, "kernel_launch: unexpected shapes (n_in %d, in0 %d, out %d, ws %zu); nothing launched\n", n_in, n_in > 0 ? in_sizes[0] : -1, out_size, ws_size); grid = -1; return; }
        int dev = 0, cus = 0, per_cu = 0;
        if (hipGetDevice(&dev) != hipSuccess || hipDeviceGetAttribute(&cus, hipDeviceAttributeMultiprocessorCount, dev) != hipSuccess) { grid = -1; return; }
        if (hipFuncSetAttribute((const void*)fwd_megakernel, hipFuncAttributeMaxDynamicSharedMemorySize, LDS_BYTES) != hipSuccess) { fprintf(stderr, "kernel_launch: hipFuncSetAttribute failed\n"); grid = -1; return; }
        if (hipOccupancyMaxActiveBlocksPerMultiprocessor(&per_cu, (const void*)fwd_megakernel, NWAVES * 64, LDS_BYTES) != hipSuccess || per_cu < 1) { fprintf(stderr, "kernel_launch: occupancy query says %d\n", per_cu); per_cu = 1; }
        (void)hipGetLastError();
        grid = cus;
    }
    if (grid < 0) return;
    if (hipMemsetAsync((char*)d_ws + WS_CTL, 0, CTL_ZERO_BYTES, stream) != hipSuccess) { fprintf(stderr, "kernel_launch: hipMemsetAsync failed\n"); return; }
    Args a{};
    for (int i = 0; i < 20; ++i) a.in[i] = (const float*)d_in[i];
    a.out = (float*)d_out; a.ws = (unsigned char*)d_ws;
    void* kargs[] = {&a};
    const hipError_t e = hipLaunchCooperativeKernel((const void*)fwd_megakernel, dim3(grid), dim3(NWAVES * 64), kargs, LDS_BYTES, stream);
    if (e != hipSuccess) fprintf(stderr, "kernel_launch: cooperative launch failed: %s (grid %d)\n", hipGetErrorString(e), grid);
}
```
